# Optimizing an MI355X kernel written in HIP

```python
import jax, jax.numpy as jnp
from jax import lax
import numpy as np

D_MODEL = 1024
BATCH = 8
SEQ = 4096
DEPTH = 4

CTX_LEN = 256
GRID_W = 64
N_MOD = 9
D_FF = 2816
FFN_RES = 0.5

POOL_WIDTH = 256
POOL_WINDOWS = (2, 4, 8, 16)
POOL_GROUP = POOL_WIDTH // 4

DN_HEADS = 4
DN_DK = 64
DN_DV = 64
DN_CONV = 5
DN_CHUNK = 64
DN_QK = DN_HEADS * DN_DK
DN_VW = DN_HEADS * DN_DV
DN_CONV_CH = 2 * DN_QK + DN_VW

ATT_HEADS = 8
ATT_KV = 2
ATT_GROUP = ATT_HEADS // ATT_KV
ATT_HD = 64
ATT_BLOCK = 128
ROPE_BASE = 10000.0

N_BRANCH = 3
MIX_WIDTH = POOL_WIDTH + DN_VW + ATT_HEADS * ATT_HD
IN_SPLITS = (POOL_WIDTH, DN_CONV_CH, DN_VW, 4 * DN_HEADS,
             ATT_HEADS * ATT_HD, ATT_KV * ATT_HD, ATT_KV * ATT_HD, N_BRANCH * D_MODEL)
IN_COLS = POOL_WIDTH + DN_CONV_CH + DN_VW + 4 * DN_HEADS + ATT_HEADS * ATT_HD + 2 * ATT_KV * ATT_HD + N_BRANCH * D_MODEL

kernel_name = "hybrid_pool_deltanet_gqa_prefix_dit"

F32 = jnp.float32


def rmsnorm(x, g, eps=1e-6):
    xf = x.astype(F32)
    y = xf * lax.rsqrt(jnp.mean(xf * xf, axis=-1, keepdims=True) + eps)
    return (y * g.astype(F32)).astype(x.dtype)


def l2norm(x, eps=1e-6):
    xf = x.astype(F32)
    return xf * lax.rsqrt(jnp.sum(xf * xf, axis=-1, keepdims=True) + eps)


def modulate(h, shift, scale):
    return h * (1.0 + scale) + shift


def swiglu(h, w_in, w_out):
    gu = h @ w_in
    g, u = jnp.split(gu, 2, axis=-1)
    return (jax.nn.silu(g) * u) @ w_out


def ffn_sublayer(s, m, g_norm, w_in, w_out):
    h = modulate(rmsnorm(s, g_norm), m[0], m[1])
    return s + FFN_RES * m[2] * swiglu(h, w_in, w_out)


def split_cols(h):
    out, o = [], 0
    for w in IN_SPLITS:
        out.append(h[..., o:o + w])
        o += w
    return out


def multiscale_pool(p, w_grp, scale):
    B, L, _ = p.shape
    pf = p.astype(F32)
    cs = jnp.concatenate([jnp.zeros((B, 1, POOL_WIDTH), F32), jnp.cumsum(pf, axis=1)], axis=1)
    t = jnp.arange(L)
    groups = []
    for gi, w in enumerate(POOL_WINDOWS):
        lo = jnp.clip(t - w // 2, 0, L)
        hi = jnp.clip(t + w - w // 2, 0, L)
        sl = slice(gi * POOL_GROUP, (gi + 1) * POOL_GROUP)
        csg = cs[:, :, sl]
        win_sum = csg[:, hi] - csg[:, lo]
        cnt = (hi - lo).astype(F32)[None, :, None]
        groups.append(win_sum / cnt - pf[:, :, sl])
    y = jnp.stack(groups, axis=2).astype(p.dtype)
    y = jnp.einsum('blgi,gio->blgo', y, w_grp).reshape(B, L, POOL_WIDTH)
    return y * scale


def short_conv(x, w):
    C = x.shape[-1]
    y = lax.conv_general_dilated(x, w[:, None, :].astype(x.dtype), window_strides=(1,), padding='SAME',
                                 dimension_numbers=('NWC', 'WIO', 'NWC'), feature_group_count=C)
    return jax.nn.silu(y)


def dn_prepare(qkv, ba, conv_w, a_log, dt_bias):
    B, L, _ = qkv.shape
    qkv = short_conv(qkv, conv_w).astype(F32)
    q = qkv[..., :DN_QK].reshape(B, L, DN_HEADS, DN_DK)
    k = qkv[..., DN_QK:2 * DN_QK].reshape(B, L, DN_HEADS, DN_DK)
    v = qkv[..., 2 * DN_QK:].reshape(B, L, DN_HEADS, DN_DV)
    q = l2norm(q) * (DN_DK ** -0.5)
    k = l2norm(k)
    ba = ba.astype(F32).reshape(B, L, 2, 2, DN_HEADS)
    beta = jax.nn.sigmoid(ba[:, :, 0])
    g = -jnp.exp(a_log.astype(F32)) * jax.nn.softplus(ba[:, :, 1] + dt_bias.astype(F32))
    to_bhl = lambda t: jnp.transpose(t, (0, 2, 1, 3))
    beta = jnp.transpose(beta, (2, 0, 3, 1))
    g = jnp.transpose(g, (2, 0, 3, 1))
    return to_bhl(q), to_bhl(k), to_bhl(v), beta, g


def gated_delta_chunked(q, k, v, beta, g, S0):
    B, H, L, DK = q.shape
    DV = v.shape[-1]
    C = DN_CHUNK
    N = L // C
    q = q.reshape(B, H, N, C, DK)
    k = k.reshape(B, H, N, C, DK)
    v = v.reshape(B, H, N, C, DV)
    beta = beta.reshape(B, H, N, C)
    G = jnp.cumsum(g.reshape(B, H, N, C), axis=-1)
    tril_incl = jnp.tril(jnp.ones((C, C), dtype=bool))
    tril_strict = jnp.tril(jnp.ones((C, C), dtype=bool), -1)
    decay_mat = jnp.exp(jnp.where(tril_incl, G[..., :, None] - G[..., None, :], -jnp.inf))
    kk = jnp.einsum('bhncd,bhnsd->bhncs', k, k)
    A = jnp.where(tril_strict, beta[..., :, None] * kk * decay_mat, 0.0)
    lhs = A + jnp.eye(C, dtype=F32)
    rhs = jnp.concatenate([v * beta[..., None], k * (beta * jnp.exp(G))[..., None]], axis=-1)
    sol = lax.linalg.triangular_solve(lhs, rhs, left_side=True, lower=True, unit_diagonal=True)
    u, w = sol[..., :DV], sol[..., DV:]
    qk = jnp.einsum('bhncd,bhnsd->bhncs', q, k) * decay_mat
    q_dec = q * jnp.exp(G)[..., None]
    k_dec = k * jnp.exp(G[..., -1:] - G)[..., None]
    g_last = jnp.exp(G[..., -1])

    def step(S, xs):
        u_n, w_n, qk_n, qd_n, kd_n, gl_n = xs
        v_new = u_n - jnp.einsum('bhcd,bhde->bhce', w_n, S)
        o_n = jnp.einsum('bhcd,bhde->bhce', qd_n, S) + jnp.einsum('bhcs,bhse->bhce', qk_n, v_new)
        S = S * gl_n[..., None, None] + jnp.einsum('bhcd,bhce->bhde', kd_n, v_new)
        return S, o_n

    xs = tuple(jnp.moveaxis(t, 2, 0) for t in (u, w, qk, q_dec, k_dec, g_last))
    S_final, o = lax.scan(step, S0, xs)
    o = jnp.moveaxis(o, 0, 2).reshape(B, H, L, DV)
    return o, S_final


def bidir_delta(q, k, v, beta, g, S0_f, S0_b):
    flip = lambda t: jnp.flip(t, axis=2)
    o_f, S_f = gated_delta_chunked(q, k, v, beta[0], g[0], S0_f)
    o_b, S_b = gated_delta_chunked(flip(q), flip(k), flip(v), flip(beta[1]), flip(g[1]), S0_b)
    return o_f + flip(o_b), S_f, S_b


def dn_output(o, z, g_norm):
    B, H, L, DV = o.shape
    o = jnp.transpose(o, (0, 2, 1, 3))
    y = rmsnorm(o, g_norm) * jax.nn.silu(z.reshape(B, L, H, DV).astype(F32))
    return y.reshape(B, L, H * DV).astype(z.dtype)


def axial_rope_tables(n_tokens):
    rows = n_tokens // GRID_W
    row = jnp.broadcast_to(jnp.arange(rows)[:, None], (rows, GRID_W)).reshape(-1)
    col = jnp.broadcast_to(jnp.arange(GRID_W)[None, :], (rows, GRID_W)).reshape(-1)
    n_freq = ATT_HD // 4
    inv = ROPE_BASE ** (-jnp.arange(n_freq, dtype=F32) / n_freq)
    ang = jnp.concatenate([row[:, None].astype(F32) * inv, col[:, None].astype(F32) * inv], axis=-1)
    return jnp.cos(ang), jnp.sin(ang)


def apply_rope(x, cos, sin):
    xf = x.astype(F32)
    x1, x2 = xf[..., 0::2], xf[..., 1::2]
    c = cos[None, :, None, :]
    s = sin[None, :, None, :]
    y = jnp.stack([x1 * c - x2 * s, x1 * s + x2 * c], axis=-1).reshape(x.shape)
    return y.astype(x.dtype)


def gqa_softmax(q, k, v):
    s = jnp.einsum('bqkgd,bskd->bkgqs', q, k).astype(F32) * (ATT_HD ** -0.5)
    p = jax.nn.softmax(s, axis=-1).astype(v.dtype)
    return jnp.einsum('bkgqs,bskd->bqkgd', p, v)


def latent_attention(q, k_lat, v_lat, k_ctx, v_ctx):
    B, L = q.shape[:2]
    k_all = jnp.concatenate([k_ctx, k_lat], axis=1)
    v_all = jnp.concatenate([v_ctx, v_lat], axis=1)
    n_blk = L // ATT_BLOCK
    qb = q.reshape(B, n_blk, ATT_BLOCK, ATT_KV, ATT_GROUP, ATT_HD).transpose(1, 0, 2, 3, 4, 5)
    o = lax.map(lambda qblk: gqa_softmax(qblk, k_all, v_all), qb)
    return o.transpose(1, 0, 2, 3, 4, 5).reshape(B, L, ATT_HEADS * ATT_HD)


def context_attention(q, k, v):
    B, Lc = q.shape[:2]
    o = gqa_softmax(q.reshape(B, Lc, ATT_KV, ATT_GROUP, ATT_HD), k, v)
    return o.reshape(B, Lc, ATT_HEADS * ATT_HD)


def split_heads(t, n):
    return t.reshape(t.shape[0], t.shape[1], n, ATT_HD)


def merge_branches(y_pool, y_dn, y_att, gates, w_branch, w_out):
    ga, gb, gc = jnp.split(jax.nn.sigmoid(gates), N_BRANCH, axis=-1)
    wa = w_branch[:POOL_WIDTH]
    wb = w_branch[POOL_WIDTH:POOL_WIDTH + DN_VW]
    wc = w_branch[POOL_WIDTH + DN_VW:]
    m = ga * (y_pool @ wa) + gb * (y_dn @ wb) + gc * (y_att @ wc)
    return m @ w_out


def mixer_sublayer(x, xc, mx, mc, p, ctx_out):
    def project(s, m):
        h = modulate(rmsnorm(s, p["norm_mix"]), m[0], m[1])
        return split_cols(h @ p["w_in"])

    pool_x, qkv_x, z_x, ba_x, aq_x, ak_x, av_x, gate_x = project(x, mx)
    pool_c, qkv_c, z_c, ba_c, aq_c, ak_c, av_c, gate_c = project(xc, mc)

    B = x.shape[0]
    S0 = jnp.zeros((B, DN_HEADS, DN_DK, DN_DV), F32)
    qd_c, kd_c, vd_c, beta_c, g_c = dn_prepare(qkv_c, ba_c, p["dn_conv"], p["dn_a_log"], p["dn_dt_bias"])
    od_c, S_f, S_b = bidir_delta(qd_c, kd_c, vd_c, beta_c, g_c, S0, S0)
    qd_x, kd_x, vd_x, beta_x, g_x = dn_prepare(qkv_x, ba_x, p["dn_conv"], p["dn_a_log"], p["dn_dt_bias"])
    od_x, _, _ = bidir_delta(qd_x, kd_x, vd_x, beta_x, g_x, S_f, S_b)

    cos, sin = axial_rope_tables(x.shape[1])
    q_x = apply_rope(rmsnorm(split_heads(aq_x, ATT_HEADS), p["q_norm"]), cos, sin)
    k_x = apply_rope(rmsnorm(split_heads(ak_x, ATT_KV), p["k_norm"]), cos, sin)
    v_x = split_heads(av_x, ATT_KV)
    k_c = rmsnorm(split_heads(ak_c, ATT_KV), p["k_norm"])
    v_c = split_heads(av_c, ATT_KV)
    att_x = latent_attention(q_x, k_x, v_x, k_c, v_c)

    y_x = merge_branches(multiscale_pool(pool_x, p["pool_w"], p["pool_scale"]),
                         dn_output(od_x, z_x, p["dn_norm"]), att_x, gate_x, p["w_branch"], p["w_out"])
    x = x + mx[2] * y_x
    if ctx_out:
        q_c = rmsnorm(split_heads(aq_c, ATT_HEADS), p["q_norm"])
        att_c = context_attention(q_c, k_c, v_c)
        y_c = merge_branches(multiscale_pool(pool_c, p["pool_w"], p["pool_scale"]),
                             dn_output(od_c, z_c, p["dn_norm"]), att_c, gate_c, p["w_branch"], p["w_out"])
        xc = xc + mc[2] * y_c
    return x, xc


def trunk_layer(x, xc, mod, mod_c, p, ctx_out):
    mx = jnp.split(mod[:, None, :], N_MOD, axis=-1)
    mc = jnp.split(mod_c[:, None, :], N_MOD, axis=-1)
    x = ffn_sublayer(x, mx[0:3], p["norm_ffn1"], p["w_ffn1_in"], p["w_ffn1_out"])
    xc = ffn_sublayer(xc, mc[0:3], p["norm_ffn1"], p["w_ffn1_in"], p["w_ffn1_out"])
    x, xc = mixer_sublayer(x, xc, mx[3:6], mc[3:6], p, ctx_out)
    x = ffn_sublayer(x, mx[6:9], p["norm_ffn2"], p["w_ffn2_in"], p["w_ffn2_out"])
    if ctx_out:
        xc = ffn_sublayer(xc, mc[6:9], p["norm_ffn2"], p["w_ffn2_in"], p["w_ffn2_out"])
    return x, xc


def setup_inputs(seed: int = 0) -> dict:
    key = jax.random.key(seed)
    ks = iter(jax.random.split(key, 40))
    D = D_MODEL
    nrm = lambda shape, scale: jax.random.normal(next(ks), shape, F32) * scale
    gain = lambda shape: 1.0 + nrm(shape, 0.02)
    a_log = jnp.log(jax.random.uniform(next(ks), (DEPTH, 2, DN_HEADS), F32, 1.0, 16.0))
    dt = jnp.exp(jax.random.uniform(next(ks), (DEPTH, 2, DN_HEADS), F32, np.log(1e-3), np.log(1e-1)))
    dt_bias = dt + jnp.log(-jnp.expm1(-dt))
    w_branch = jnp.concatenate([nrm((DEPTH, POOL_WIDTH, D), POOL_WIDTH ** -0.5),
                                nrm((DEPTH, DN_VW, D), DN_VW ** -0.5),
                                nrm((DEPTH, ATT_HEADS * ATT_HD, D), (ATT_HEADS * ATT_HD) ** -0.5)], axis=1)
    return {
        "x": nrm((BATCH, SEQ, D), 1.0),
        "c": nrm((BATCH, D), 1.0),
        "ctx": nrm((BATCH, CTX_LEN, D), 1.0),
        "c_ctx": nrm((D,), 1.0),
        "w_ada": nrm((DEPTH, D, N_MOD * D), 0.5 * D ** -0.5),
        "b_ada": nrm((DEPTH, N_MOD * D), 0.02),
        "norm_ffn1": gain((DEPTH, D)),
        "w_ffn1_in": nrm((DEPTH, D, 2 * D_FF), D ** -0.5),
        "w_ffn1_out": nrm((DEPTH, D_FF, D), D_FF ** -0.5),
        "norm_mix": gain((DEPTH, D)),
        "w_in": nrm((DEPTH, D, IN_COLS), D ** -0.5),
        "pool_w": nrm((DEPTH, 4, POOL_GROUP, POOL_GROUP), POOL_GROUP ** -0.5),
        "pool_scale": gain((DEPTH, POOL_WIDTH)),
        "dn_conv": nrm((DEPTH, DN_CONV, DN_CONV_CH), DN_CONV ** -0.5),
        "dn_a_log": a_log,
        "dn_dt_bias": dt_bias,
        "dn_norm": gain((DEPTH, DN_DV)),
        "q_norm": gain((DEPTH, ATT_HD)),
        "k_norm": gain((DEPTH, ATT_HD)),
        "w_branch": w_branch,
        "w_out": nrm((DEPTH, D, D), D ** -0.5),
        "norm_ffn2": gain((DEPTH, D)),
        "w_ffn2_in": nrm((DEPTH, D, 2 * D_FF), D ** -0.5),
        "w_ffn2_out": nrm((DEPTH, D_FF, D), D_FF ** -0.5),
        "norm_final": gain((D,)),
    }


def reference(x, c, ctx, c_ctx, w_ada, b_ada, norm_ffn1, w_ffn1_in, w_ffn1_out, norm_mix, w_in,
              pool_w, pool_scale, dn_conv, dn_a_log, dn_dt_bias, dn_norm, q_norm, k_norm,
              w_branch, w_out, norm_ffn2, w_ffn2_in, w_ffn2_out, norm_final):
    s_lat = jax.nn.silu(c)
    s_ctx = jax.nn.silu(c_ctx)[None]
    xc = ctx
    for l in range(DEPTH):
        mod = s_lat @ w_ada[l] + b_ada[l]
        mod_c = s_ctx @ w_ada[l] + b_ada[l]
        p = {
            "norm_ffn1": norm_ffn1[l], "w_ffn1_in": w_ffn1_in[l], "w_ffn1_out": w_ffn1_out[l],
            "norm_mix": norm_mix[l], "w_in": w_in[l],
            "pool_w": pool_w[l], "pool_scale": pool_scale[l],
            "dn_conv": dn_conv[l], "dn_a_log": dn_a_log[l], "dn_dt_bias": dn_dt_bias[l], "dn_norm": dn_norm[l],
            "q_norm": q_norm[l], "k_norm": k_norm[l],
            "w_branch": w_branch[l], "w_out": w_out[l],
            "norm_ffn2": norm_ffn2[l], "w_ffn2_in": w_ffn2_in[l], "w_ffn2_out": w_ffn2_out[l],
        }
        x, xc = trunk_layer(x, xc, mod, mod_c, p, ctx_out=(l < DEPTH - 1))
    return rmsnorm(x, norm_final)
```

```cpp
#include <hip/hip_runtime.h>
#include <hip/hip_cooperative_groups.h>
#include <cstdio>
#include <cstdint>
namespace cg = cooperative_groups;
#ifndef DBL_SCAN
#define DBL_SCAN 1
#endif
#ifndef DBL_CHUNK
#define DBL_CHUNK 1
#endif
#ifndef DBL_MERGE
#define DBL_MERGE 1
#endif
#ifndef ABL
#define ABL 0
#define PROBE_SCAN1 0
#endif
#ifndef EN_MASK
#define EN_MASK 0xFFFF
#endif

__device__ __forceinline__ int ltid() { int t = threadIdx.x; asm volatile("" : "+v"(t)); return t; }
__device__ __forceinline__ int lbid() { int t = blockIdx.x; asm volatile("" : "+s"(t)); return t; }
__device__ __forceinline__ int lgdim() { int t = gridDim.x; asm volatile("" : "+s"(t)); return t; }
namespace pg8 {
#define PG8_LAS __attribute__((address_space(3)))
typedef unsigned short bf16_t;
typedef short bf16x8 __attribute__((ext_vector_type(8)));
typedef float f32x4 __attribute__((ext_vector_type(4)));
typedef unsigned u32x4 __attribute__((ext_vector_type(4)));
constexpr int BM = 256, BK = 64, HALF = 128, HTB = HALF * BK * 2  , STAGE_BYTES = 8 * HTB, NXCD = 8, WGM = 4;

__host__ __device__ __forceinline__ int lds_byte(int r, int c) { const int st = (r >> 4) * 2 + (c >> 5), rr = r & 15, cc = c & 31, ob = rr * 64 + cc * 2; return st * 1024 + (ob ^ (((ob >> 9) & 1) << 5)); }
__host__ __device__ __forceinline__ void stage_rc(int b, int& R, int& C) { const int st = b / 1024, sb = b % 1024, swz = sb ^ (((sb >> 9) & 1) << 5); R = (st >> 1) * 16 + swz / 64; C = (st & 1) * 32 + (swz % 64) / 2; }
__host__ __device__ __forceinline__ int perm32(int rho) { const int n = rho >> 4, i = rho & 15; return 8 * (i >> 2) + 4 * n + (i & 3); }

struct Unit { int pm, pn, k0, nt, part; };
struct Gemm { const bf16_t* A; const bf16_t* Bt; int M, N, K; };

struct StaticOrder {
    int nM, nN, nwg, G, c;
    __host__ __device__ __forceinline__ void init(int M, int N, int G_, int c_) { nM = M / BM; nN = N / BM; nwg = nM * nN; G = G_; c = c_; }
    __host__ __device__ __forceinline__ bool next(int i, Unit& u) const {
        const long L = (long)i * G + c; if (L >= nwg) return false;
        int wgid = (int)L; { const int q = nwg / NXCD, r = nwg % NXCD, xcd = wgid % NXCD, off = wgid / NXCD; wgid = (xcd < r ? xcd * (q + 1) : r * (q + 1) + (xcd - r) * q) + off; }
        const int nig = WGM * nN, gid = wgid / nig, fm = gid * WGM, gsz = (nM - fm) < WGM ? (nM - fm) : WGM;
        u.pm = fm + ((wgid % nig) % gsz); u.pn = (wgid % nig) / gsz; u.k0 = 0; u.nt = 0; u.part = 0; return true;
    }
    __device__ __forceinline__ void a_ready(const Unit&) const {}
    __device__ __forceinline__ void done(const Unit&) const {}
};
struct MergeOrder {
    StaticOrder F;
    __host__ __device__ __forceinline__ void init(int M, int N, int G_, int c_) { F.init(M, N, G_, c_); }
    __host__ __device__ __forceinline__ bool next(int i, Unit& u) const {
        const int it = i / 3, br = i - 3 * it; int wgid = it * F.G + F.c; const bool valid = wgid < F.nwg; wgid = valid ? wgid : F.nwg - 1;
        { const int qq = F.nwg / NXCD, rr = F.nwg % NXCD, xcd = wgid % NXCD, off = wgid / NXCD; wgid = (xcd < rr ? xcd * (qq + 1) : rr * (qq + 1) + (xcd - rr) * qq) + off; }
        const int nig = WGM * F.nN, gid = wgid / nig, fm = gid * WGM, gsz = (F.nM - fm) < WGM ? (F.nM - fm) : WGM;
        u.pm = fm + ((wgid % nig) % gsz); u.pn = (wgid % nig) / gsz; u.k0 = br == 0 ? 0 : (br == 1 ? 4 : 8); u.nt = br == 2 ? 8 : 4; u.part = br;
        return valid;
    }
    __device__ __forceinline__ void a_ready(const Unit&) const {}
    __device__ __forceinline__ void done(const Unit&) const {}
};
struct SplitOrder {
    StaticOrder F; int nf, G, c, pm0, nN, ntail, parts, q, r;
    __host__ __device__ __forceinline__ void init(int MF, int MTOT, int N, int K, int G_, int c_, int parts_) {
        F.init(MF, N, G_, c_); G = G_; c = c_; nf = c < F.nwg ? (F.nwg - c + G - 1) / G : 0; pm0 = MF / BM; nN = N / BM; parts = parts_; ntail = ((MTOT - MF) / BM) * nN * parts;
        const int pairs = K / (2 * BK); q = pairs / parts; r = pairs % parts; }
    __host__ __device__ __forceinline__ bool next(int i, Unit& u) const {
        const bool full = i < nf;
        int wgid = i * G + c; wgid = wgid < F.nwg ? wgid : F.nwg - 1;
        { const int qq = F.nwg / NXCD, rr = F.nwg % NXCD, xcd = wgid % NXCD, off = wgid / NXCD; wgid = (xcd < rr ? xcd * (qq + 1) : rr * (qq + 1) + (xcd - rr) * qq) + off; }
        const int nig = WGM * F.nN, gid = wgid / nig, fm = gid * WGM, gsz = (F.nM - fm) < WGM ? (F.nM - fm) : WGM;
        const int fpm = fm + ((wgid % nig) % gsz), fpn = (wgid % nig) / gsz;
        const int j = (i - nf) * G + c, tile = j / parts, p = j % parts;
        u.pm = full ? fpm : pm0 + tile / nN; u.pn = full ? fpn : tile % nN; u.nt = full ? 0 : 2 * (q + (p < r ? 1 : 0)); u.k0 = full ? 0 : 2 * (p * q + (p < r ? p : r)); u.part = full ? 0 : p;
        return full || j < ntail;
    }
    __device__ __forceinline__ void a_ready(const Unit&) const {}
    __device__ __forceinline__ void done(const Unit&) const {}
};
__device__ __forceinline__ unsigned cvt_pk_bf16(float lo, float hi) { unsigned r; asm volatile("v_cvt_pk_bf16_f32 %0, %1, %2" : "=v"(r) : "v"(lo), "v"(hi)); return r; }
constexpr int XML = 32768;
__device__ __forceinline__ float fsilu(float x) { return x * __builtin_amdgcn_rcpf(1.f + __expf(-x)); }
__device__ __forceinline__ float fsigm(float x) { return __builtin_amdgcn_rcpf(1.f + __expf(-x)); }
struct EpiSwiglu {
    static constexpr bool PERM = true, AFTER_DRAIN = false, KEEP_ACC = false;
    bf16_t* O;
    __device__ __forceinline__ void operator()(const f32x4 (&acc)[2][2][4][2], const Unit& u, int wr, int wc, int fr, int fq) const {
        const int row0 = u.pm * BM + wr * 64 + fr, col0 = u.pn * 128 + wc * 32 + 8 * fq;
#pragma unroll
        for (int ai = 0; ai < 2; ++ai)
#pragma unroll
            for (int m = 0; m < 4; ++m) { bf16_t* rowp = O + (size_t)(row0 + ai * HALF + m * 16) * 2816 + col0;
                const f32x4 g0 = acc[ai][0][m][0], g1 = acc[ai][0][m][1], u0 = acc[ai][1][m][0], u1 = acc[ai][1][m][1];
                u32x4 w; w.x = cvt_pk_bf16(fsilu(g0[0]) * u0[0], fsilu(g0[1]) * u0[1]); w.y = cvt_pk_bf16(fsilu(g0[2]) * u0[2], fsilu(g0[3]) * u0[3]);
                w.z = cvt_pk_bf16(fsilu(g1[0]) * u1[0], fsilu(g1[1]) * u1[1]); w.w = cvt_pk_bf16(fsilu(g1[2]) * u1[2], fsilu(g1[3]) * u1[3]);
                *(u32x4*)rowp = w; }
    }
};
struct EpiResid {
    static constexpr bool PERM = false, AFTER_DRAIN = false, KEEP_ACC = false;
    const float* xin_l; float* xo_l; float* xc; const float* gate; float* part; float coef;
    __device__ __forceinline__ void operator()(const f32x4 (&acc)[2][2][4][2], const Unit& u, int wr, int wc, int fr, int fq) const {
        const int row0 = u.pm * BM + wr * 64 + fr, col0 = u.pn * BM + wc * 32 + 4 * fq;
        const bool lat = u.pm * BM < XML;
        const float* gp = gate + (size_t)(lat ? ((u.pm * BM) >> 12) : 8) * 9216 + col0;
        f32x4 gv[2][2];
#pragma unroll
        for (int bj = 0; bj < 2; ++bj)
#pragma unroll
            for (int n = 0; n < 2; ++n) gv[bj][n] = *(const f32x4*)(gp + bj * HALF + n * 16) * coef;
        if (u.nt) {
#pragma unroll
            for (int ai = 0; ai < 2; ++ai)
#pragma unroll
                for (int m = 0; m < 4; ++m) { float* pp = part + ((size_t)u.part * 2048 + (row0 + ai * HALF + m * 16 - XML)) * 1024 + col0;
#pragma unroll
                    for (int bj = 0; bj < 2; ++bj)
#pragma unroll
                        for (int n = 0; n < 2; ++n) *(f32x4*)(pp + bj * HALF + n * 16) = gv[bj][n] * acc[ai][bj][m][n]; }
        } else {
#pragma unroll
            for (int ai = 0; ai < 2; ++ai)
#pragma unroll
                for (int mp = 0; mp < 2; ++mp) { f32x4 xv[2][2][2];
#pragma unroll
                    for (int mm = 0; mm < 2; ++mm) { const int row = row0 + ai * HALF + (2 * mp + mm) * 16;
                        const float* xi = (lat ? xin_l + (size_t)row * 1024 : xc + (size_t)(row - XML) * 1024) + col0;
#pragma unroll
                        for (int bj = 0; bj < 2; ++bj)
#pragma unroll
                            for (int n = 0; n < 2; ++n) xv[mm][bj][n] = *(const f32x4*)(xi + bj * HALF + n * 16); }
#pragma unroll
                    for (int mm = 0; mm < 2; ++mm) { const int row = row0 + ai * HALF + (2 * mp + mm) * 16;
                        float* xo = (lat ? xo_l + (size_t)row * 1024 : xc + (size_t)(row - XML) * 1024) + col0;
#pragma unroll
                        for (int bj = 0; bj < 2; ++bj)
#pragma unroll
                            for (int n = 0; n < 2; ++n) *(f32x4*)(xo + bj * HALF + n * 16) = xv[mm][bj][n] + gv[bj][n] * acc[ai][bj][2 * mp + mm][n]; } }
        }
    }
};
struct EpiProj {
    static constexpr bool PERM = true, AFTER_DRAIN = false, KEEP_ACC = false;
    bf16_t* pool; bf16_t* qkv; bf16_t* z; bf16_t* aq; bf16_t* kv; bf16_t* gate;
    __device__ __forceinline__ void operator()(const f32x4 (&acc)[2][2][4][2], const Unit& u, int wr, int wc, int fr, int fq) const {
        const int pn = u.pn; bf16_t* base; int ldc, ct;
        if (pn == 0) { base = pool; ldc = 256; ct = 0; } else if (pn < 4) { base = qkv; ldc = 768; ct = pn - 1; } else if (pn == 4) { base = z; ldc = 256; ct = 0; }
        else if (pn < 7) { base = aq; ldc = 512; ct = pn - 5; } else if (pn == 7) { base = kv; ldc = 256; ct = 0; } else { base = gate; ldc = 3072; ct = pn - 8; }
        const int row0 = u.pm * BM + wr * 64 + fr, col0 = ct * 256 + wc * 32 + 8 * fq;
#pragma unroll
        for (int ai = 0; ai < 2; ++ai)
#pragma unroll
            for (int m = 0; m < 4; ++m) { bf16_t* rowp = base + (size_t)(row0 + ai * HALF + m * 16) * ldc + col0;
#pragma unroll
                for (int bj = 0; bj < 2; ++bj) { const f32x4 v0 = acc[ai][bj][m][0], v1 = acc[ai][bj][m][1];
                    u32x4 w; w.x = cvt_pk_bf16(v0[0], v0[1]); w.y = cvt_pk_bf16(v0[2], v0[3]); w.z = cvt_pk_bf16(v1[0], v1[1]); w.w = cvt_pk_bf16(v1[2], v1[3]);
                    *(u32x4*)(rowp + bj * HALF) = w; } }
    }
};
struct EpiGate {
    static constexpr bool PERM = true, AFTER_DRAIN = false, KEEP_ACC = true;
    const bf16_t* gate; bf16_t* mbf;
    __device__ __forceinline__ void operator()(const f32x4 (&)[2][2][4][2], const Unit&, int, int, int, int) const {}
    __device__ __forceinline__ void mid(f32x4 (&acc)[2][2][4][2], const Unit& u, int wr, int wc, int fr, int fq) const {
        const int row0 = u.pm * BM + wr * 64 + fr, col0 = u.pn * BM + wc * 32 + 8 * fq; const int br = u.part;
#pragma unroll
        for (int ai = 0; ai < 2; ++ai)
#pragma unroll
            for (int m = 0; m < 4; ++m) { const size_t row = (size_t)(row0 + ai * HALF + m * 16);
#pragma unroll
                for (int bj = 0; bj < 2; ++bj) { const int c = col0 + bj * HALF; const bf16_t* gp = gate + row * 3072 + c;
                    if (br < 2) { const u32x4 a = *(const u32x4*)(gp + br * 1024), b = *(const u32x4*)(gp + (br + 1) * 1024);
#pragma unroll
                        for (int e = 0; e < 8; ++e) { const unsigned aw = a[e >> 1], bw = b[e >> 1];
                            float za = __uint_as_float((e & 1) ? (aw & 0xffff0000u) : (aw << 16)), zb = __uint_as_float((e & 1) ? (bw & 0xffff0000u) : (bw << 16));
                            za = fminf(fmaxf(za, -30.f), 30.f); zb = fminf(fmaxf(zb, -30.f), 30.f);
                            acc[ai][bj][m][e >> 2][e & 3] *= (1.f + __expf(-zb)) * __builtin_amdgcn_rcpf(1.f + __expf(-za)); } }
                    else { const u32x4 a = *(const u32x4*)(gp + 2048); float o[8];
#pragma unroll
                        for (int e = 0; e < 8; ++e) { const unsigned aw = a[e >> 1]; float za = __uint_as_float((e & 1) ? (aw & 0xffff0000u) : (aw << 16)); za = fminf(fmaxf(za, -30.f), 30.f);
                            o[e] = acc[ai][bj][m][e >> 2][e & 3] * __builtin_amdgcn_rcpf(1.f + __expf(-za)); }
                        u32x4 w; w.x = cvt_pk_bf16(o[0], o[1]); w.y = cvt_pk_bf16(o[2], o[3]); w.z = cvt_pk_bf16(o[4], o[5]); w.w = cvt_pk_bf16(o[6], o[7]);
                        *(u32x4*)(mbf + row * 1024 + c) = w; } } }
    }
};
template <class Epi, class Sched, bool ALIGN_EPI = false, bool SP2 = false>
__device__ __forceinline__ void gemm_phase(PG8_LAS unsigned char* lds, const Gemm g, const Sched& S, const Epi& E) {
    const int tid = ltid(), wid = __builtin_amdgcn_readfirstlane(tid >> 6), lane = tid & 63, wr = wid >> 2, wc = wid & 3, fr = lane & 15, fq = lane >> 4;
    const int K = g.K, nt = K / BK;
    unsigned voffA[2], voffB[2];
#pragma unroll
    for (int i = 0; i < 2; ++i) { int R, C; stage_rc(tid * 16 + i * 8192, R, C); const int Rb = Epi::PERM ? ((R & ~31) + perm32(R & 31)) : R;
        voffA[i] = (unsigned)(R * K + C) * 2u; voffB[i] = (unsigned)(Rb * K + C) * 2u; }
    const size_t kstep = (size_t)(BK * 2);
    const size_t hstep = (size_t)HALF * K * 2;
    const size_t tstep = 2 * hstep;
    const unsigned ldsw = (unsigned)wid * 1024u;
    const int aoff = lds_byte(wr * 64 + fr, fq * 8), boff = lds_byte(wc * 32 + fr, fq * 8);
#define PG8_SA(b, h) (((b) * 2 + (h)) * HTB)
#define PG8_SB(b, h) ((4 + (b) * 2 + (h)) * HTB)
#define PG8_STAGE(bufoff, gbase, voff) do { _Pragma("unroll") for (int _i = 0; _i < 2; ++_i) \
        __builtin_amdgcn_global_load_lds((const unsigned*)((const char*)(gbase) + (voff)[_i]), (PG8_LAS unsigned*)(lds + (bufoff) + ldsw + _i * 8192), 16, 0, 0); } while (0)
#define PG8_LDA(dst, b, h) do { _Pragma("unroll") for (int m = 0; m < 4; ++m) _Pragma("unroll") for (int k = 0; k < 2; ++k) dst[m][k] = *(const PG8_LAS bf16x8*)(lds + PG8_SA(b, h) + aoff + m * 2048 + k * 1024); } while (0)
#define PG8_LDB(dst, b, h) do { _Pragma("unroll") for (int n = 0; n < 2; ++n) _Pragma("unroll") for (int k = 0; k < 2; ++k) dst[n][k] = *(const PG8_LAS bf16x8*)(lds + PG8_SB(b, h) + boff + n * 2048 + k * 1024); } while (0)
#define PG8_MMA(ai, bj, At, Bt) do { __builtin_amdgcn_s_setprio(1); _Pragma("unroll") for (int m = 0; m < 4; ++m) _Pragma("unroll") for (int n = 0; n < 2; ++n) _Pragma("unroll") for (int k = 0; k < 2; ++k) \
        acc[ai][bj][m][n] = __builtin_amdgcn_mfma_f32_16x16x32_bf16(Bt[n][k], At[m][k], acc[ai][bj][m][n], 0, 0, 0); __builtin_amdgcn_s_setprio(0); } while (0)
#define PG8_WAIT_V(n) asm volatile("s_waitcnt vmcnt(" #n ")" ::: "memory")
#define PG8_WAIT_L(n) asm volatile("s_waitcnt lgkmcnt(" #n ")" ::: "memory")
#define PG8_BAR __builtin_amdgcn_s_barrier()
#define PG8_SCHED __builtin_amdgcn_sched_barrier(0)
    Unit cur, nxt; int ui = 0;
    if (!S.next(0, cur)) return;
    f32x4 acc[2][2][4][2];
#pragma unroll
    for (int a = 0; a < 2; ++a)
#pragma unroll
        for (int b = 0; b < 2; ++b)
#pragma unroll
            for (int m = 0; m < 4; ++m)
#pragma unroll
                for (int n = 0; n < 2; ++n) acc[a][b][m][n] = (f32x4){0.f, 0.f, 0.f, 0.f};
    bf16x8 At[4][2], B0[2][2], B1[2][2];
    const char* cA = (const char*)g.A + (size_t)cur.pm * tstep + (size_t)cur.k0 * kstep; const char* cB = (const char*)g.Bt + (size_t)cur.pn * tstep + (size_t)cur.k0 * kstep;
    S.a_ready(cur);
    if constexpr (SP2) {
        PG8_STAGE(PG8_SB(0, 0), cB, voffB); PG8_STAGE(PG8_SB(0, 1), cB + hstep, voffB); PG8_STAGE(PG8_SA(0, 0), cA, voffA); PG8_STAGE(PG8_SA(0, 1), cA + hstep, voffA);
        if (wr == 1) PG8_BAR;
        PG8_WAIT_V(2); PG8_BAR;
        PG8_STAGE(PG8_SB(1, 0), cB + kstep, voffB); PG8_STAGE(PG8_SA(1, 0), cA + kstep, voffA); PG8_STAGE(PG8_SB(1, 1), cB + hstep + kstep, voffB);
        PG8_WAIT_V(6); PG8_BAR;
    } else {
        PG8_STAGE(PG8_SB(0, 0), cB, voffB); PG8_STAGE(PG8_SA(0, 0), cA, voffA); PG8_STAGE(PG8_SB(0, 1), cB + hstep, voffB); PG8_STAGE(PG8_SA(0, 1), cA + hstep, voffA);
        if (wr == 1) PG8_BAR;
        PG8_WAIT_V(4); PG8_BAR;
        PG8_STAGE(PG8_SB(1, 0), cB + kstep, voffB); PG8_STAGE(PG8_SA(1, 0), cA + kstep, voffA); PG8_STAGE(PG8_SB(1, 1), cB + hstep + kstep, voffB);
        PG8_WAIT_V(6); PG8_BAR;
    }
    for (;;) {
        const bool has_next = S.next(ui + 1, nxt);
        const char* nA = has_next ? (const char*)g.A + (size_t)nxt.pm * tstep + (size_t)nxt.k0 * kstep : cA; const char* nB = has_next ? (const char*)g.Bt + (size_t)nxt.pn * tstep + (size_t)nxt.k0 * kstep : cB;
        const int unt = cur.nt ? cur.nt : nt;
        for (int t = 0; t < unt; t += 2) {
            const bool last = (t == unt - 2);
            const char* a1 = cA + (size_t)(t + 1) * kstep;
            const char* a2 = last ? nA : cA + (size_t)(t + 2) * kstep; const char* b2 = last ? nB : cB + (size_t)(t + 2) * kstep;
            const char* a3 = a2 + kstep; const char* b3 = b2 + kstep;
            if (last && has_next) S.a_ready(nxt);
            if constexpr (SP2) {
            PG8_LDB(B0, 0, 0); PG8_LDB(B1, 0, 1); PG8_SCHED; PG8_LDA(At, 0, 0); PG8_STAGE(PG8_SA(1, 1), a1 + hstep, voffA);
            PG8_WAIT_V(8); PG8_WAIT_L(0); PG8_BAR; PG8_MMA(0, 0, At, B0); PG8_MMA(0, 1, At, B1); PG8_BAR; PG8_SCHED;
            PG8_LDA(At, 0, 1); PG8_STAGE(PG8_SB(0, 0), b2, voffB); PG8_STAGE(PG8_SB(0, 1), b2 + hstep, voffB); PG8_STAGE(PG8_SA(0, 0), a2, voffA);
            PG8_WAIT_V(8); PG8_WAIT_L(0); PG8_BAR; PG8_MMA(1, 0, At, B0); PG8_MMA(1, 1, At, B1); PG8_BAR; PG8_SCHED;
            PG8_LDB(B0, 1, 0); PG8_LDB(B1, 1, 1); PG8_SCHED; PG8_LDA(At, 1, 0); PG8_STAGE(PG8_SA(0, 1), a2 + hstep, voffA);
            PG8_WAIT_V(8); PG8_WAIT_L(0); PG8_BAR; PG8_MMA(0, 0, At, B0); PG8_MMA(0, 1, At, B1); PG8_BAR; PG8_SCHED;
            PG8_LDA(At, 1, 1); PG8_STAGE(PG8_SB(1, 0), b3, voffB); PG8_STAGE(PG8_SB(1, 1), b3 + hstep, voffB); PG8_STAGE(PG8_SA(1, 0), a3, voffA);
            PG8_WAIT_V(8); PG8_WAIT_L(0); PG8_BAR; PG8_MMA(1, 0, At, B0); PG8_MMA(1, 1, At, B1); PG8_BAR; PG8_SCHED;
            } else {
            PG8_LDB(B0, 0, 0); PG8_SCHED; PG8_LDA(At, 0, 0); PG8_STAGE(PG8_SA(1, 1), a1 + hstep, voffA);
            PG8_WAIT_L(8); PG8_BAR; PG8_WAIT_L(0); PG8_MMA(0, 0, At, B0); PG8_BAR; PG8_SCHED;
            PG8_LDB(B1, 0, 1); PG8_STAGE(PG8_SB(0, 0), b2, voffB);
            PG8_BAR; PG8_WAIT_L(0); PG8_MMA(0, 1, At, B1); PG8_BAR;
            PG8_LDA(At, 0, 1); PG8_STAGE(PG8_SA(0, 0), a2, voffA);
            PG8_BAR; PG8_WAIT_L(0); PG8_MMA(1, 0, At, B0); PG8_BAR; PG8_SCHED;
            PG8_STAGE(PG8_SB(0, 1), b2 + hstep, voffB);
            PG8_WAIT_V(6); PG8_BAR; PG8_MMA(1, 1, At, B1); PG8_BAR;
            PG8_LDB(B0, 1, 0); PG8_SCHED; PG8_LDA(At, 1, 0); PG8_STAGE(PG8_SA(0, 1), a2 + hstep, voffA);
            PG8_WAIT_L(8); PG8_BAR; PG8_WAIT_L(0); PG8_MMA(0, 0, At, B0); PG8_BAR; PG8_SCHED;
            PG8_LDB(B1, 1, 1); PG8_STAGE(PG8_SB(1, 0), b3, voffB);
            PG8_BAR; PG8_WAIT_L(0); PG8_MMA(0, 1, At, B1); PG8_BAR;
            PG8_LDA(At, 1, 1); PG8_STAGE(PG8_SA(1, 0), a3, voffA);
            PG8_BAR; PG8_WAIT_L(0); PG8_MMA(1, 0, At, B0); PG8_BAR; PG8_SCHED;
            PG8_STAGE(PG8_SB(1, 1), b3 + hstep, voffB);
            PG8_WAIT_V(6); PG8_BAR; PG8_MMA(1, 1, At, B1); PG8_BAR;
            }
        }
        if constexpr (ALIGN_EPI) { if (wr == 0) PG8_BAR; }
        if constexpr (!Epi::AFTER_DRAIN) { if constexpr (Epi::KEEP_ACC) E.mid(acc, cur, wr, wc, fr, fq); else E(acc, cur, wr, wc, fr, fq); S.done(cur); }
        if (!has_next) break;
        if (!Epi::KEEP_ACC || cur.part >= 2) {
#pragma unroll
        for (int a = 0; a < 2; ++a)
#pragma unroll
            for (int b = 0; b < 2; ++b)
#pragma unroll
                for (int m = 0; m < 4; ++m)
#pragma unroll
                    for (int n = 0; n < 2; ++n) acc[a][b][m][n] = (f32x4){0.f, 0.f, 0.f, 0.f}; }
        cur = nxt; cA = nA; cB = nB; ++ui;
        if constexpr (ALIGN_EPI) { if (wr == 1) PG8_BAR; }
    }
    PG8_WAIT_V(0);
    if constexpr (!ALIGN_EPI) { if (wr == 0) PG8_BAR; }
    PG8_BAR;
    if constexpr (Epi::AFTER_DRAIN) { E.fused(acc, cur, wr, wc, fr, fq, lds, wid, lane); S.done(cur); }
#undef PG8_SA
#undef PG8_SB
#undef PG8_STAGE
#undef PG8_LDA
#undef PG8_LDB
#undef PG8_MMA
#undef PG8_WAIT_V
#undef PG8_WAIT_L
#undef PG8_BAR
#undef PG8_SCHED
}
}
#include <hip/hip_bf16.h>
#include <cmath>
namespace attn_body {
using bf16=__hip_bfloat16;
using bf16x8=__attribute__((ext_vector_type(8)))short;
using s16x4=__attribute__((ext_vector_type(4)))short;
using f32x16=__attribute__((ext_vector_type(16)))float;
using u32x4=__attribute__((ext_vector_type(4)))unsigned;
constexpr int D=64,QP=1024,KP=128;
constexpr int NW=8,QBLK=32,QB=QBLK*NW,KVBLK=64;
__device__ __forceinline__ int crow(int r,int hi){return (r&3)+8*(r>>2)+4*hi;}
#define SBAR() __builtin_amdgcn_sched_barrier(0)
__device__ __forceinline__ void cmask(f32x16&p0,f32x16&p1,int jb,int qrel,int hi){
  const float NEG=-INFINITY; int kb=64*jb+4*hi;
  #pragma unroll
  for(int r=0;r<16;++r){int kv=kb+(r&3)+8*(r>>2); if(kv>qrel)p0[r]=NEG; if(kv+32>qrel)p1[r]=NEG;}
}

constexpr int NSLOT=3, SLOTB=8192;
constexpr int LDS_K=0, LDS_V=NSLOT*SLOTB, LDS_WS=2*NSLOT*SLOTB, LDS_OST=LDS_WS+NW*64*4, LDS_BYTES=LDS_OST+NW*4096;
constexpr float C2=0.125f*1.4426950408889634f;
__device__ __forceinline__ void glds16(const void*gsrc,unsigned lds_dst){unsigned keep;
  asm volatile("s_mov_b32 %0, m0\n\ts_mov_b32 m0, %2\n\ts_nop 0\n\tglobal_load_lds_dwordx4 %1, off\n\ts_mov_b32 m0, %0":"=&s"(keep):"v"(gsrc),"s"(lds_dst):"memory");}
__device__ __forceinline__ float max3f(float a,float b,float c){float r;asm("v_max3_f32 %0, %1, %2, %3":"=v"(r):"v"(a),"v"(b),"v"(c));return r;}
__device__ __forceinline__ float max2f(float a,float b){float r;asm("v_max_f32_e32 %0, %1, %2":"=v"(r):"v"(a),"v"(b));return r;}
__device__ __forceinline__ float fadd_s(float a,float b){float r;asm("v_add_f32_e32 %0, %1, %2":"=v"(r):"v"(a),"v"(b));return r;}
__device__ __forceinline__ float fsub_s(float a,float b){float r;asm("v_sub_f32_e32 %0, %1, %2":"=v"(r):"v"(a),"v"(b));return r;}
typedef float f32x2_t __attribute__((ext_vector_type(2))); typedef __bf16 bf16x2_t __attribute__((ext_vector_type(2)));
__device__ __forceinline__ unsigned cvtpk_s(float lo,float hi){f32x2_t v={lo,hi};bf16x2_t b=__builtin_convertvector(v,bf16x2_t);return __builtin_bit_cast(unsigned,b);}
#define WAIT_BAR(N) asm volatile("s_waitcnt vmcnt(" #N ") lgkmcnt(0)\n\ts_barrier":::"memory")

__device__ __forceinline__ void qkt(f32x16&p0,f32x16&p1,const char*Kslot,const bf16x8*qr,const f32x16&negm,int r32,int hi){
  const char*kb=Kslot+hi*1024+r32*16;
  #pragma unroll
  for(int d0=0;d0<4;++d0){
    const bf16x8 b0=*reinterpret_cast<const bf16x8*>(kb+d0*2048);
    const bf16x8 b1=*reinterpret_cast<const bf16x8*>(kb+d0*2048+512);
    if(d0==0){p0=__builtin_amdgcn_mfma_f32_32x32x16_bf16(b0,qr[0],negm,0,0,0);p1=__builtin_amdgcn_mfma_f32_32x32x16_bf16(b1,qr[0],negm,0,0,0);}
    else{p0=__builtin_amdgcn_mfma_f32_32x32x16_bf16(b0,qr[d0],p0,0,0,0);p1=__builtin_amdgcn_mfma_f32_32x32x16_bf16(b1,qr[d0],p1,0,0,0);}}
}
typedef __attribute__((address_space(3))) const char* lds_cptr;
typedef short v4i16_t __attribute__((ext_vector_type(4)));
__device__ __forceinline__ void kload8(bf16x8*kf,lds_cptr kp){
  kf[0]=*(const __attribute__((address_space(3))) bf16x8*)(kp);      kf[1]=*(const __attribute__((address_space(3))) bf16x8*)(kp+512);
  kf[2]=*(const __attribute__((address_space(3))) bf16x8*)(kp+2048); kf[3]=*(const __attribute__((address_space(3))) bf16x8*)(kp+2560);
  kf[4]=*(const __attribute__((address_space(3))) bf16x8*)(kp+4096); kf[5]=*(const __attribute__((address_space(3))) bf16x8*)(kp+4608);
  kf[6]=*(const __attribute__((address_space(3))) bf16x8*)(kp+6144); kf[7]=*(const __attribute__((address_space(3))) bf16x8*)(kp+6656);
}
__device__ __forceinline__ void kload2(bf16x8*kf,lds_cptr kp,int j){ kf[2*j]=*(const __attribute__((address_space(3))) bf16x8*)(kp+j*2048); kf[2*j+1]=*(const __attribute__((address_space(3))) bf16x8*)(kp+j*2048+512); }
__device__ __forceinline__ s16x4 vtr(lds_cptr p){ return __builtin_bit_cast(s16x4,__builtin_amdgcn_ds_read_tr16_b64_v4i16((__attribute__((address_space(3))) v4i16_t*)p)); }
__device__ __forceinline__ float rowmax(const f32x16&p0,const f32x16&p1){
  float a=max3f(p0[0],p0[1],p1[0]),b=max3f(p0[2],p0[3],p1[1]);a=max3f(a,p1[2],p1[3]);
  #pragma unroll
  for(int r=4;r<16;r+=4){a=max3f(a,p0[r],p0[r+1]);b=max3f(b,p0[r+2],p0[r+3]);a=max3f(a,p1[r],p1[r+1]);b=max3f(b,p1[r+2],p1[r+3]);}
  const float m=max2f(a,b);
  auto rr=__builtin_amdgcn_permlane32_swap(__float_as_uint(m),__float_as_uint(m),false,false);
  return max2f(__uint_as_float(rr[0]),__uint_as_float(rr[1]));
}
__device__ __forceinline__ void pv(f32x16*o,int vb,bf16x8 pa0,bf16x8 pa1,bf16x8 pa2,bf16x8 pa3){
  #pragma unroll
  for(int d0=0;d0<2;++d0){s16x4 lo[4],hi[4];
    #pragma unroll
    for(int ks=0;ks<4;++ks){
      asm volatile("ds_read_b64_tr_b16 %0,%1 offset:%c2":"=&v"(lo[ks]):"v"(vb),"i"(d0*4096+ks*1024):"memory");
      asm volatile("ds_read_b64_tr_b16 %0,%1 offset:%c2":"=&v"(hi[ks]):"v"(vb),"i"(d0*4096+ks*1024+512):"memory");}
    asm volatile("s_waitcnt lgkmcnt(0)":::"memory");SBAR();
    #define PK(k) (bf16x8){lo[k][0],lo[k][1],lo[k][2],lo[k][3],hi[k][0],hi[k][1],hi[k][2],hi[k][3]}
    o[d0]=__builtin_amdgcn_mfma_f32_32x32x16_bf16(pa0,PK(0),o[d0],0,0,0);
    o[d0]=__builtin_amdgcn_mfma_f32_32x32x16_bf16(pa1,PK(1),o[d0],0,0,0);
    o[d0]=__builtin_amdgcn_mfma_f32_32x32x16_bf16(pa2,PK(2),o[d0],0,0,0);
    o[d0]=__builtin_amdgcn_mfma_f32_32x32x16_bf16(pa3,PK(3),o[d0],0,0,0);
    #undef PK
  }
}

#ifndef ATTN_STORE16
#define ATTN_STORE16(p,v) (*(u32x4*)(p)=(v))
#endif
template<int THRL> __device__ __forceinline__ void attn_unit(const bf16*Qu,const bf16*__restrict__ Kh,const bf16*__restrict__ Vh,bf16*Ou,const int NT,char*shm){
  const int tid=ltid(),lane=tid&63,r32=lane&31,hi=lane>>5; const int wid=__builtin_amdgcn_readfirstlane(tid>>6);
  const bf16*Qw=Qu+(long)(wid*QBLK)*QP;
  const unsigned lds0=(unsigned)(uintptr_t)shm;
  float*wsf=(float*)(shm+LDS_WS)+wid*64;
  const bf16*ksrc=Kh+(long)lane*KP+wid*8;
  const bf16*vsrc=Vh+(long)(16*(wid&3)+(lane>>2))*KP+(wid>>2)*32+(lane&3)*8;
  const unsigned kdst=lds0+LDS_K+wid*1024, vdst=lds0+LDS_V+wid*1024;
  #define DMA_K(t,slot) glds16(ksrc+(long)(t)*KVBLK*KP,(unsigned)__builtin_amdgcn_readfirstlane(kdst+(slot)))
  #define DMA_V(t,slot) glds16(vsrc+(long)(t)*KVBLK*KP,(unsigned)__builtin_amdgcn_readfirstlane(vdst+(slot)))
  const int vb0=(int)(lds0+LDS_V)+((lane>>4)&1)*32+(lane&3)*8+(4*hi+((lane&15)>>2))*64;
  const char*Kbase=shm+LDS_K; bf16x8 kf[8];
  const lds_cptr shm3=(lds_cptr)shm; const lds_cptr kp0=shm3+LDS_K+hi*1024+r32*16; const lds_cptr vp0=shm3+LDS_V+((lane>>4)&1)*32+(lane&3)*8+(4*hi+((lane&15)>>2))*64;
  DMA_K(0,0);DMA_V(0,0);DMA_K(1,SLOTB);
  bf16x8 qr[4];
  #pragma unroll
  for(int d0=0;d0<4;++d0)qr[d0]=*reinterpret_cast<const bf16x8*>(&Qw[(long)r32*QP+d0*16+hi*8]);
  float mhat=0.f,l_reg=0.f;f32x16 o[2];o[0]=f32x16{};o[1]=f32x16{};f32x16 negm=f32x16{};asm volatile("":"+v"(negm));
  #define CMASK(P0,P1,t) do{}while(0)
  bool resc=false;
  #define START(P0,P1) do{ const float rm=rowmax(P0,P1); resc=false; \
    { const float dl=rm; mhat=fadd_s(mhat,dl); \
      _Pragma("unroll") for(int r=0;r<16;++r){P0[r]=fsub_s(P0[r],dl);P1[r]=fsub_s(P1[r],dl);} \
      _Pragma("unroll") for(int r=0;r<16;++r)negm[r]=-mhat; asm volatile("":"+v"(negm)); } \
    _Pragma("unroll") for(int r=0;r<16;++r)P0[r]=__builtin_amdgcn_exp2f(P0[r]); }while(0)
  #define RESC() do{ if(resc){ asm volatile("s_waitcnt lgkmcnt(0)":::"memory"); \
      _Pragma("unroll") for(int d_=0;d_<2;++d_) _Pragma("unroll") for(int r=0;r<16;++r)o[d_][r]*=wsf[crow(r,hi)]; } }while(0)
  f32x16 pA0,pA1,pB0,pB1;
  int sl_prev=0,sl_cur=0,sl_next=SLOTB;
  #define ROT() do{sl_prev=sl_cur;sl_cur=sl_next;sl_next=(sl_next==(NSLOT-1)*SLOTB)?0:sl_next+SLOTB;}while(0)
  DMA_K(2,2*SLOTB);
  WAIT_BAR(3);
  qkt(pA0,pA1,Kbase,qr,negm,r32,hi);asm volatile("s_nop 15\n\ts_nop 7":"+v"(pA0),"+v"(pA1));CMASK(pA0,pA1,0);
  START(pA0,pA1);
  _Pragma("unroll") for(int r=0;r<16;++r)pA1[r]=__builtin_amdgcn_exp2f(pA1[r]);
  WAIT_BAR(0);
  DMA_K(3,0);DMA_V(1,SLOTB);
  ROT();
  kload8(kf,kp0+sl_cur);
  WAIT_BAR(2);
  s16x4 vlo[8],vhi[8]; u32x4 pw0,pw1,pw2,pw3;
  #define PKW(P,B) cvtpk_s(P[B],P[B+1])
  #define PAF(k) __builtin_bit_cast(bf16x8,pw##k)
  #define VFR(i) (bf16x8){vlo[i][0],vlo[i][1],vlo[i][2],vlo[i][3],vhi[i][0],vhi[i][1],vhi[i][2],vhi[i][3]}
  #define PIN(x) asm volatile("":"+v"(x))
  #define MX3(a,b,c) __builtin_fmaxf(__builtin_fmaxf((a),(b)),(c))
  #define GAPA(MF,A0,A1,A2,A3,W0,W1,PW) do{ MF; sacc+=A0; sacc+=A1; sacc+=A2; sacc+=A3; PIN(sacc); W0; W1; PIN(PW); SBAR(); }while(0)
  #define EX(v) __builtin_amdgcn_exp2f(v)
  #define GAPB(MF,X,B) do{ MF; X[B]=EX(X[B]); X[B+1]=EX(X[B+1]); X[B+2]=EX(X[B+2]); X[B+3]=EX(X[B+3]); PIN(X); SBAR(); }while(0)
  #define VRD(i) do{ vlo[i]=vtr(vp_+(((i)>>2)*4096+((i)&3)*1024)); vhi[i]=vtr(vp_+(((i)>>2)*4096+((i)&3)*1024+512)); }while(0)
  #define KRD(G,j) do{ if(G){ kload2(kf,kp0+sl_next,j); SBAR(); } }while(0)
  #define STEP(C0,C1,P0,P1,t,GK,GV,GL) do{ SBAR(); \
    const lds_cptr vp_=vp0+sl_prev; \
    VRD(0); SBAR(); float sacc=(P0[0]+P0[1]); \
    GAPA(C0=__builtin_amdgcn_mfma_f32_32x32x16_bf16(kf[0],qr[0],negm,0,0,0), P0[2],P0[3],P0[4],P0[5],     pw0[0]=PKW(P0,0), pw0[1]=PKW(P0,2), pw0); \
    VRD(4); SBAR(); GAPA(C1=__builtin_amdgcn_mfma_f32_32x32x16_bf16(kf[1],qr[0],negm,0,0,0), P0[6],P0[7],P0[8],P0[9],     pw0[2]=PKW(P0,4), pw0[3]=PKW(P0,6), pw0); \
    VRD(1); SBAR(); GAPA(C0=__builtin_amdgcn_mfma_f32_32x32x16_bf16(kf[2],qr[1],C0,0,0,0),   P0[10],P0[11],P0[12],P0[13], pw1[0]=PKW(P0,8), pw1[1]=PKW(P0,10), pw1); \
    VRD(5); SBAR(); GAPA(C1=__builtin_amdgcn_mfma_f32_32x32x16_bf16(kf[3],qr[1],C1,0,0,0),   P0[14],P0[15],P1[0],P1[1],   pw1[2]=PKW(P0,12),pw1[3]=PKW(P0,14), pw1); \
    VRD(2); SBAR(); GAPA(C0=__builtin_amdgcn_mfma_f32_32x32x16_bf16(kf[4],qr[2],C0,0,0,0),   P1[2],P1[3],P1[4],P1[5],     pw2[0]=PKW(P1,0), pw2[1]=PKW(P1,2), pw2); \
    VRD(6); SBAR(); GAPA(C1=__builtin_amdgcn_mfma_f32_32x32x16_bf16(kf[5],qr[2],C1,0,0,0),   P1[6],P1[7],P1[8],P1[9],     pw2[2]=PKW(P1,4), pw2[3]=PKW(P1,6), pw2); \
    VRD(3); SBAR(); GAPA(C0=__builtin_amdgcn_mfma_f32_32x32x16_bf16(kf[6],qr[3],C0,0,0,0),   P1[10],P1[11],P1[12],P1[13], pw3[0]=PKW(P1,8), pw3[1]=PKW(P1,10), pw3); \
    VRD(7); SBAR(); GAPA(C1=__builtin_amdgcn_mfma_f32_32x32x16_bf16(kf[7],qr[3],C1,0,0,0),   P1[14],P1[15],0.f,0.f,       pw3[2]=PKW(P1,12),pw3[3]=PKW(P1,14), pw3); \
    l_reg+=sacc; \
    if(GK){DMA_K((t)+3,sl_cur);} if(GV){DMA_V((t)+1,sl_next);} \
    CMASK(C0,C1,t); \
    { float a=MX3(C0[0],C0[1],C1[0]),b=MX3(C0[2],C0[3],C1[1]); a=MX3(a,C1[2],C1[3]); \
      _Pragma("unroll") for(int r=4;r<16;r+=4){a=MX3(a,C0[r],C0[r+1]);b=MX3(b,C0[r+2],C0[r+3]);a=MX3(a,C1[r],C1[r+1]);b=MX3(b,C1[r+2],C1[r+3]);} \
      float rm=__builtin_fmaxf(a,b); { auto rr=__builtin_amdgcn_permlane32_swap(__float_as_uint(rm),__float_as_uint(rm),false,false); rm=__builtin_fmaxf(__uint_as_float(rr[0]),__uint_as_float(rr[1])); } \
      resc=false; \
      if(__builtin_expect(__any(rm>(float)THRL),0)){ const float dl=__builtin_fmaxf(rm,0.f); mhat+=dl; \
        _Pragma("unroll") for(int r=0;r<16;++r){C0[r]-=dl;C1[r]-=dl;} \
        _Pragma("unroll") for(int r=0;r<16;++r)negm[r]=-mhat; asm volatile("":"+v"(negm)); \
        const float f=__builtin_amdgcn_exp2f(-dl); l_reg*=f; if(hi==0)wsf[r32]=f; resc=true; } } \
    SBAR(); \
    GAPB(o[0]=__builtin_amdgcn_mfma_f32_32x32x16_bf16(PAF(0),VFR(0),o[0],0,0,0), C0,0); \
    GAPB(o[1]=__builtin_amdgcn_mfma_f32_32x32x16_bf16(PAF(0),VFR(4),o[1],0,0,0), C0,4); \
    KRD(GL,0); GAPB(o[0]=__builtin_amdgcn_mfma_f32_32x32x16_bf16(PAF(1),VFR(1),o[0],0,0,0), C0,8); \
    KRD(GL,1); GAPB(o[1]=__builtin_amdgcn_mfma_f32_32x32x16_bf16(PAF(1),VFR(5),o[1],0,0,0), C0,12); \
    KRD(GL,2); GAPB(o[0]=__builtin_amdgcn_mfma_f32_32x32x16_bf16(PAF(2),VFR(2),o[0],0,0,0), C1,0); \
    KRD(GL,3); GAPB(o[1]=__builtin_amdgcn_mfma_f32_32x32x16_bf16(PAF(2),VFR(6),o[1],0,0,0), C1,4); \
    GAPB(o[0]=__builtin_amdgcn_mfma_f32_32x32x16_bf16(PAF(3),VFR(3),o[0],0,0,0), C1,8); \
    GAPB(o[1]=__builtin_amdgcn_mfma_f32_32x32x16_bf16(PAF(3),VFR(7),o[1],0,0,0), C1,12); \
    }while(0)
  int t=1;
  #undef CMASK
  #define CMASK(P0,P1,t) do{}while(0)
  for(;t+5<NT;t+=2){
    STEP(pB0,pB1,pA0,pA1,t,true,true,true);     WAIT_BAR(2); RESC(); ROT();
    STEP(pA0,pA1,pB0,pB1,t+1,true,true,true);   WAIT_BAR(2); RESC(); ROT();
  }
  #undef CMASK
  #define CMASK(P0,P1,t) do{}while(0)
  #define ENDW(tt) do{ if((tt)+3<NT){WAIT_BAR(2);} else if((tt)+2<NT){WAIT_BAR(1);} else {WAIT_BAR(0);} }while(0)
  for(;t+1<NT;t+=2){
    STEP(pB0,pB1,pA0,pA1,t,(t+3<NT),(t+1<NT),(t+1<NT));       ENDW(t);   RESC(); ROT();
    STEP(pA0,pA1,pB0,pB1,t+1,(t+4<NT),(t+2<NT),(t+2<NT));     ENDW(t+1); RESC(); ROT();
  }
  STEP(pB0,pB1,pA0,pA1,NT-1,false,false,false); RESC();
  { float sacc=pB0[0]+pB0[1]; _Pragma("unroll") for(int r=2;r<16;++r)sacc+=pB0[r]; _Pragma("unroll") for(int r=0;r<16;++r)sacc+=pB1[r]; l_reg+=sacc;
    pw0=(u32x4){PKW(pB0,0),PKW(pB0,2),PKW(pB0,4),PKW(pB0,6)};pw1=(u32x4){PKW(pB0,8),PKW(pB0,10),PKW(pB0,12),PKW(pB0,14)};pw2=(u32x4){PKW(pB1,0),PKW(pB1,2),PKW(pB1,4),PKW(pB1,6)};pw3=(u32x4){PKW(pB1,8),PKW(pB1,10),PKW(pB1,12),PKW(pB1,14)};
    SBAR(); pv(o,vb0+sl_cur,PAF(0),PAF(1),PAF(2),PAF(3)); }
  #undef PKW
  #undef PAF
  #undef VFR
  #undef PIN
  #undef MX3
  #undef GAPA
  #undef GAPB
  #undef EX
  #undef VRD
  #undef KRD
  #undef STEP
  #undef ENDW
  {auto rr=__builtin_amdgcn_permlane32_swap(__float_as_uint(l_reg),__float_as_uint(l_reg),false,false);l_reg=__uint_as_float(rr[0])+__uint_as_float(rr[1]);}
  if(hi==0)wsf[32+r32]=l_reg;asm volatile("s_waitcnt lgkmcnt(0)":::"memory");
  float rli[16];
  #pragma unroll
  for(int r=0;r<16;++r)rli[r]=__builtin_amdgcn_rcpf(wsf[32+crow(r,hi)]);
  bf16*Ow=Ou+(long)(wid*QBLK)*QP;
  { bf16*stg=(bf16*)(shm+LDS_OST)+wid*2048;
    #pragma unroll
    for(int r=0;r<16;++r){const int orow=crow(r,hi);
      #pragma unroll
      for(int d0=0;d0<2;++d0)stg[orow*64+d0*32+r32]=__float2bfloat16(o[d0][r]*rli[r]);}
    asm volatile("s_waitcnt lgkmcnt(0)":::"memory");
    #pragma unroll
    for(int i=0;i<4;++i){const int row=i*8+(lane>>3),ch=lane&7; const u32x4 v=*(const u32x4*)(stg+row*64+ch*8); ATTN_STORE16(Ow+(long)row*QP+ch*8,v);} }
  asm volatile("s_waitcnt lgkmcnt(0)\n\ts_barrier":::"memory");
  #undef DMA_K
  #undef DMA_V
  #undef CMASK
  #undef START
  #undef RESC
  #undef ROT
}
constexpr int ATTN_LDS_BYTES=LDS_BYTES;
#undef SBAR
#undef WAIT_BAR
}
typedef unsigned short bf16_t;
typedef short bf16x8 __attribute__((ext_vector_type(8)));
typedef float f32x4 __attribute__((ext_vector_type(4)));
constexpr int DM = 1024, NB = 8, SEQ = 4096, CTXL = 256, DEPTH = 4, DFF = 2816;
constexpr int ML = NB * SEQ, MC = NB * CTXL, MT = ML + MC;
constexpr int INC = 5136, MODW = 9 * DM, NCH = 68, KVR = CTXL + SEQ;
static_assert(ML == pg8::XML, "row split");
constexpr size_t MiB = 1u << 20;
constexpr size_t WS_MOD = 0, WS_CTR = 1536 * 1024, WS_BAR = WS_CTR + 4096, WS_CTL_BYTES = 65536, WS_XC = 2 * MiB, WS_H = 10 * MiB;
constexpr size_t WS_Y = WS_H;
constexpr size_t WS_WB = 78 * MiB;
constexpr size_t WS_W1IN = WS_WB, WS_W1OUT = WS_W1IN + (size_t)5632 * 1024 * 2, WS_WIN = WS_W1OUT + (size_t)1024 * 2816 * 2, WS_WA = WS_WIN + (size_t)5120 * 1024 * 2,
                 WS_WBB = WS_WA + (size_t)1024 * 256 * 2, WS_WC = WS_WBB + (size_t)1024 * 256 * 2, WS_WOUT = WS_WC + (size_t)1024 * 512 * 2, WS_W2IN = WS_WOUT + (size_t)1024 * 1024 * 2,
                 WS_W2OUT = WS_W2IN + (size_t)5632 * 1024 * 2, WS_WB_END = WS_W2OUT + (size_t)1024 * 2816 * 2;
constexpr size_t WS_R = 125 * MiB;
static_assert(WS_WB_END <= WS_R, "ws map");
constexpr size_t WS_ACT = WS_R, WS_PGATE = WS_R, WS_PZ = WS_R + 204 * MiB, WS_PAQ = WS_R + 221 * MiB, WS_PKV = WS_R + 255 * MiB, WS_PQKV = WS_R + 272 * MiB,
                 WS_OF = WS_PQKV, WS_OB = WS_PAQ  , WS_MBF = WS_PQKV, WS_PPOOL = WS_R + 323 * MiB, WS_DNU = WS_R + 340 * MiB, WS_M32 = WS_DNU, WS_DNW = WS_R + 374 * MiB,
                 WS_DNQK = WS_R + 408 * MiB, WS_DNKT = WS_R + 442 * MiB, WS_DNQN = WS_R + 476 * MiB, WS_DNG = WS_R + 493 * MiB, WS_BA = WS_R + 495 * MiB, WS_KATT = WS_R + 498 * MiB, WS_VATT = WS_KATT + (size_t)NB * KVR * 128 * 2, WS_END = WS_R + 516 * MiB;
constexpr int LDS_BYTES = 147456;

struct Args { const float* in[25]; float* out; unsigned char* ws; };
enum { I_X = 0, I_C, I_CTX, I_CCTX, I_WADA, I_BADA, I_NF1, I_F1IN, I_F1OUT, I_NMIX, I_WIN, I_POOLW, I_POOLS, I_CONV, I_ALOG, I_DTB, I_DNN, I_QN, I_KN, I_WBR, I_WOUT, I_NF2, I_F2IN, I_F2OUT, I_NFIN };

__device__ __forceinline__ float bf2f(unsigned v) { return __uint_as_float(v << 16); }
typedef float f32x2_c __attribute__((ext_vector_type(2))); typedef __bf16 bf16x2_c __attribute__((ext_vector_type(2)));
__device__ __forceinline__ unsigned pk2(float lo, float hi) { f32x2_c v = {lo, hi}; bf16x2_c b = __builtin_convertvector(v, bf16x2_c); return __builtin_bit_cast(unsigned, b); }
__device__ __forceinline__ float wave_sum(float v) {
#pragma unroll
    for (int o = 32; o >= 1; o >>= 1) v += __shfl_xor(v, o);
    return v;
}
__device__ __forceinline__ void unpack8(const uint4 r, float* v) {
    v[0] = __uint_as_float(r.x << 16); v[1] = __uint_as_float(r.x & 0xffff0000u); v[2] = __uint_as_float(r.y << 16); v[3] = __uint_as_float(r.y & 0xffff0000u);
    v[4] = __uint_as_float(r.z << 16); v[5] = __uint_as_float(r.z & 0xffff0000u); v[6] = __uint_as_float(r.w << 16); v[7] = __uint_as_float(r.w & 0xffff0000u);
}
__device__ __forceinline__ uint4 pack8(const float* v) { uint4 r; r.x = pk2(v[0], v[1]); r.y = pk2(v[2], v[3]); r.z = pk2(v[4], v[5]); r.w = pk2(v[6], v[7]); return r; }
__device__ __forceinline__ int permk(int k) { return (k & 32) | (((k >> 2) & 3) << 3) | (((k >> 4) & 1) << 2) | (k & 3); }
__device__ __forceinline__ int unpermk(int p) { return (p & 32) | (((p >> 2) & 1) << 4) | (((p >> 3) & 3) << 2) | (p & 3); }

__device__ __forceinline__ void mods_phase(const Args& a, float* ldsf, float* MOD) {
    const int tid = ltid();
    float* s = ldsf; float* red = ldsf + 9 * 1024;
    for (int i = tid; i < 9 * 1024; i += 512) { const int r = i >> 10, k = i & 1023; const float v = r < 8 ? a.in[I_C][r * 1024 + k] : a.in[I_CCTX][k]; s[i] = v / (1.f + expf(-v)); }
    __syncthreads();
    for (int task = lbid(); task < DEPTH * 144; task += lgdim()) {
        const int l = task / 144, cb = task % 144, cl = tid & 63, kg = tid >> 6;
        const float* w = a.in[I_WADA] + ((size_t)l * 1024 + kg * 128) * MODW + cb * 64 + cl;
        float acc[9];
#pragma unroll
        for (int r = 0; r < 9; ++r) acc[r] = 0.f;
#pragma unroll 16
        for (int k = 0; k < 128; ++k) { const float wv = w[(size_t)k * MODW];
#pragma unroll
            for (int r = 0; r < 9; ++r) acc[r] += s[r * 1024 + kg * 128 + k] * wv; }
#pragma unroll
        for (int r = 0; r < 9; ++r) red[(kg * 9 + r) * 64 + cl] = acc[r];
        __syncthreads();
        for (int i = tid; i < 9 * 64; i += 512) { const int r = i >> 6, cc = i & 63; float v = 0.f;
#pragma unroll
            for (int g8 = 0; g8 < 8; ++g8) v += red[(g8 * 9 + r) * 64 + cc];
            MOD[((size_t)l * 9 + r) * MODW + cb * 64 + cc] = v + a.in[I_BADA][(size_t)l * MODW + cb * 64 + cc]; }
        __syncthreads();
    }
}

__device__ __forceinline__ int tmap(int map, int n) { return map == 0 ? n : (map == 1 ? ((n >> 8) * 128 + (n & 127) + ((n >> 7) & 1) * DFF) : (n < 1280 ? n : n + 16)); }
__device__ __forceinline__ void tconv_tile(const float* src, int pitch, int K, int map, bf16_t* dst, int t, float* tile, int tid) {
    const int ntk = K / 64, n0 = (t / ntk) * 64, k0 = (t % ntk) * 64, sc0 = tmap(map, n0);
#pragma unroll
    for (int i = 0; i < 2; ++i) { const int kk = (tid >> 4) + 32 * i, c4 = (tid & 15) * 4;
        const float4 v = *(const float4*)(src + (size_t)(k0 + kk) * pitch + sc0 + c4);
        float* p = tile + kk * 65 + c4; p[0] = v.x; p[1] = v.y; p[2] = v.z; p[3] = v.w; }
    __syncthreads();
    { const int nn = tid >> 3, kq = tid & 7; float v[8];
#pragma unroll
      for (int j = 0; j < 8; ++j) v[j] = tile[(kq * 8 + j) * 65 + nn];
      *(uint4*)(dst + (size_t)(n0 + nn) * K + k0 + kq * 8) = pack8(v); }
    __syncthreads();
}
__device__ __forceinline__ void tconv_mat(const float* src, int pitch, int K, int Nout, int map, bf16_t* dst, int& goff, float* tile) {
    const int tid = ltid(), G = lgdim(), ntk = K / 64, ntiles = (Nout / 64) * ntk;
    int t = (lbid() - goff % G + G) % G;
    for (; t < ntiles; t += G) {
        const int n0 = (t / ntk) * 64, k0 = (t % ntk) * 64, sc0 = tmap(map, n0);
#pragma unroll
        for (int i = 0; i < 2; ++i) { const int kk = (tid >> 4) + 32 * i, c4 = (tid & 15) * 4;
            const float4 v = *(const float4*)(src + (size_t)(k0 + kk) * pitch + sc0 + c4);
            float* p = tile + kk * 65 + c4; p[0] = v.x; p[1] = v.y; p[2] = v.z; p[3] = v.w; }
        __syncthreads();
        { const int nn = tid >> 3, kq = tid & 7; float v[8];
#pragma unroll
          for (int j = 0; j < 8; ++j) v[j] = tile[(kq * 8 + j) * 65 + nn];
          *(uint4*)(dst + (size_t)(n0 + nn) * K + k0 + kq * 8) = pack8(v); }
        __syncthreads();
    }
    goff += ntiles;
}
__device__ __forceinline__ void weights_phase(const Args& a, int l, unsigned char* ws, float* ldsf, bool first3, bool last2) {
    int goff = 0;
    if (first3) {
    tconv_mat(a.in[I_F1IN] + (size_t)l * 1024 * 5632, 5632, 1024, 5632, 1, (bf16_t*)(ws + WS_W1IN), goff, ldsf);
    tconv_mat(a.in[I_F1OUT] + (size_t)l * 2816 * 1024, 1024, 2816, 1024, 0, (bf16_t*)(ws + WS_W1OUT), goff, ldsf);
    tconv_mat(a.in[I_WIN] + (size_t)l * 1024 * INC, INC, 1024, 5120, 2, (bf16_t*)(ws + WS_WIN), goff, ldsf); }
    tconv_mat(a.in[I_WBR] + (size_t)l * 1024 * 1024, 1024, 1024, 1024, 0, (bf16_t*)(ws + WS_WA), goff, ldsf);
    tconv_mat(a.in[I_WOUT] + (size_t)l * 1024 * 1024, 1024, 1024, 1024, 0, (bf16_t*)(ws + WS_WOUT), goff, ldsf);
    if (last2) {
    tconv_mat(a.in[I_F2IN] + (size_t)l * 1024 * 5632, 5632, 1024, 5632, 1, (bf16_t*)(ws + WS_W2IN), goff, ldsf);
    tconv_mat(a.in[I_F2OUT] + (size_t)l * 2816 * 1024, 1024, 2816, 1024, 0, (bf16_t*)(ws + WS_W2OUT), goff, ldsf); }
}

__device__ __forceinline__ void norm_phase(const float* xl, const float* xc, const float* gn, const float* modl, int jshift, bf16_t* H, int nrows, float* xcw, const float* PART, int nparts) {
    const int tid_ = ltid(), lane = tid_ & 63, gw = lbid() * 8 + (tid_ >> 6), nw = lgdim() * 8;
    float4 gq[4], nx[4];
#pragma unroll
    for (int i = 0; i < 4; ++i) { gq[i] = *(const float4*)(gn + i * 256 + lane * 4); nx[i] = make_float4(0.f, 0.f, 0.f, 0.f); }
    if (gw < nrows) { const float* x0 = gw < ML ? xl + (size_t)gw * 1024 : xc + (size_t)(gw - ML) * 1024;
#pragma unroll
        for (int i = 0; i < 4; ++i) nx[i] = *(const float4*)(x0 + i * 256 + lane * 4); }
    for (int row = gw; row < nrows; row += nw) {
        const float* sh = modl + (size_t)(row < ML ? (row >> 12) : 8) * MODW + jshift * 1024; const float* sc = sh + 1024;
        float4 v[4]; float ss = 0.f;
#pragma unroll
        for (int i = 0; i < 4; ++i) v[i] = nx[i];
        { const int nrow = row + nw;
          if (nrow < nrows) { const float* xn = nrow < ML ? xl + (size_t)nrow * 1024 : xc + (size_t)(nrow - ML) * 1024;
#pragma unroll
              for (int i = 0; i < 4; ++i) nx[i] = *(const float4*)(xn + i * 256 + lane * 4); } }
        if (row >= ML && nparts > 0) {
            const float* pp0 = PART + (size_t)(row - ML) * 1024 + lane * 4;
#pragma unroll
            for (int i = 0; i < 4; ++i) { float4 d[8];
#pragma unroll
                for (int p = 0; p < 8; ++p) d[p] = p < nparts ? *(const float4*)(pp0 + (size_t)p * MC * 1024 + i * 256) : make_float4(0.f, 0.f, 0.f, 0.f);
#pragma unroll
                for (int p = 0; p < 8; ++p) { v[i].x += d[p].x; v[i].y += d[p].y; v[i].z += d[p].z; v[i].w += d[p].w; } }
#pragma unroll
            for (int i = 0; i < 4; ++i) *(float4*)(xcw + (size_t)(row - ML) * 1024 + i * 256 + lane * 4) = v[i]; }
#pragma unroll
        for (int i = 0; i < 4; ++i) ss += v[i].x * v[i].x + v[i].y * v[i].y + v[i].z * v[i].z + v[i].w * v[i].w;
        ss = wave_sum(ss); const float rstd = rsqrtf(ss * (1.f / 1024.f) + 1e-6f);
#pragma unroll
        for (int i = 0; i < 4; ++i) { const int c = i * 256 + lane * 4; const float4 g = gq[i], s4 = *(const float4*)(sh + c), c4 = *(const float4*)(sc + c);
            uint2 o; o.x = pk2(v[i].x * rstd * g.x * (1.f + c4.x) + s4.x, v[i].y * rstd * g.y * (1.f + c4.y) + s4.y);
            o.y = pk2(v[i].z * rstd * g.z * (1.f + c4.z) + s4.z, v[i].w * rstd * g.w * (1.f + c4.w) + s4.w);
            *(uint2*)(H + (size_t)row * 1024 + c) = o; }
    }
}
__device__ __forceinline__ void final_norm_phase(float* x, const float* gn) {
    const int tid_ = ltid(), lane = tid_ & 63, gw = lbid() * 8 + (tid_ >> 6), nw = lgdim() * 8;
    for (int row = gw; row < ML; row += nw) {
        float* xr = x + (size_t)row * 1024; float4 v[4]; float ss = 0.f;
#pragma unroll
        for (int i = 0; i < 4; ++i) { v[i] = *(const float4*)(xr + i * 256 + lane * 4); ss += v[i].x * v[i].x + v[i].y * v[i].y + v[i].z * v[i].z + v[i].w * v[i].w; }
        ss = wave_sum(ss); const float rstd = rsqrtf(ss * (1.f / 1024.f) + 1e-6f);
#pragma unroll
        for (int i = 0; i < 4; ++i) { const int c = i * 256 + lane * 4; const float4 g = *(const float4*)(gn + c);
            *(float4*)(xr + c) = make_float4(v[i].x * rstd * g.x, v[i].y * rstd * g.y, v[i].z * rstd * g.z, v[i].w * rstd * g.w); }
    }
}

__device__ __forceinline__ void ba_phase(const float* win_l, const bf16_t* H, float* BA, float* ldsf) {
    const int tid = ltid(), lane = tid & 63, gw = lbid() * 8 + (tid >> 6), nw = lgdim() * 8;
    for (int i = tid; i < 16 * 1024; i += 512) { const int k = i >> 4, j = i & 15; ldsf[j * 1024 + k] = win_l[(size_t)k * INC + 1280 + j]; }
    __syncthreads();
    unsigned hv[8], hn[8];
#pragma unroll
    for (int i = 0; i < 8; ++i) hn[i] = gw < MT ? *(const unsigned*)(H + (size_t)gw * 1024 + i * 128 + lane * 2) : 0u;
    for (int row = gw; row < MT; row += nw) {
#pragma unroll
        for (int i = 0; i < 8; ++i) hv[i] = hn[i];
        const int nrow = row + nw;
        if (nrow < MT) {
#pragma unroll
            for (int i = 0; i < 8; ++i) hn[i] = *(const unsigned*)(H + (size_t)nrow * 1024 + i * 128 + lane * 2); }
        float mine = 0.f;
#pragma unroll 1
        for (int j = 0; j < 16; ++j) { float a = 0.f;
#pragma unroll
            for (int i = 0; i < 8; ++i) { const float2 w = *(const float2*)(ldsf + j * 1024 + i * 128 + lane * 2); a += __uint_as_float(hv[i] << 16) * w.x + __uint_as_float(hv[i] & 0xffff0000u) * w.y; }
            a = wave_sum(a); mine = (lane == j) ? a : mine; }
        if (lane < 16) BA[(size_t)row * 16 + lane] = mine;
    }
    __syncthreads();
}

__device__ __forceinline__ void pool_load_w(const float* pw, float* ldsf, int tid) { for (int i = tid; i < 4096; i += 512) *(float4*)(ldsf + i * 4) = *(const float4*)(pw + i * 4); }
__device__ __forceinline__ void pool_task(const bf16_t* PP, const float* pscale, bf16_t* YP, float* ldsf, int task, int tid) {
    float* w = ldsf; float* p = ldsf + 4 * 4096; float* d = p + 80 * 64;
    {
        const int tile = task >> 2, g = task & 3;
        int seqbase, L, t0;
        if (tile < 512) { seqbase = (tile >> 6) * SEQ; L = SEQ; t0 = (tile & 63) * 64; } else { const int c = tile - 512; seqbase = ML + (c >> 2) * CTXL; L = CTXL; t0 = (c & 3) * 64; }
        for (int i = tid; i < 80 * 8; i += 512) { const int tt = i >> 3, c8 = (i & 7) * 8, tok = t0 - 8 + tt; float v[8];
            if (tok >= 0 && tok < L) unpack8(*(const uint4*)(PP + (size_t)(seqbase + tok) * 256 + g * 64 + c8), v);
            else {
#pragma unroll
                for (int j = 0; j < 8; ++j) v[j] = 0.f; }
            *(float4*)(p + tt * 64 + c8) = make_float4(v[0], v[1], v[2], v[3]); *(float4*)(p + tt * 64 + c8 + 4) = make_float4(v[4], v[5], v[6], v[7]); }
        __syncthreads();
        { const int hw = 1 << g, c = tid & 63, tb = (tid >> 6) * 8;
          int tg = t0 + tb, lo = max(tg - hw, 0), hi = min(tg + hw, L); float sacc = 0.f;
          for (int u = lo; u < hi; ++u) sacc += p[(u - t0 + 8) * 64 + c];
          d[tb * 65 + c] = sacc / (float)(hi - lo) - p[(tb + 8) * 64 + c];
#pragma unroll
          for (int k = 1; k < 8; ++k) { ++tg; const int nlo = max(tg - hw, 0), nhi = min(tg + hw, L);
              if (nlo > lo) sacc -= p[(lo - t0 + 8) * 64 + c];
              if (nhi > hi) sacc += p[(hi - t0 + 8) * 64 + c];
              lo = nlo; hi = nhi;
              d[(tb + k) * 65 + c] = sacc / (float)(hi - lo) - p[(tb + k + 8) * 64 + c]; } }
        __syncthreads();
        { const int t = tid >> 3, og = (tid & 7) * 8; float acc[8]; const float* wg = w + g * 4096;
#pragma unroll
          for (int j = 0; j < 8; ++j) acc[j] = 0.f;
#pragma unroll 8
          for (int i = 0; i < 64; ++i) { const float dv = d[t * 65 + i]; const float4 w0 = *(const float4*)(wg + i * 64 + og), w1 = *(const float4*)(wg + i * 64 + og + 4);
              acc[0] += dv * w0.x; acc[1] += dv * w0.y; acc[2] += dv * w0.z; acc[3] += dv * w0.w; acc[4] += dv * w1.x; acc[5] += dv * w1.y; acc[6] += dv * w1.z; acc[7] += dv * w1.w; }
#pragma unroll
          for (int j = 0; j < 8; ++j) acc[j] *= pscale[g * 64 + og + j];
          *(uint4*)(YP + (size_t)(seqbase + t0 + t) * 1024 + g * 64 + og) = pack8(acc); }
    }
}

__device__ __forceinline__ void norm_rope8(float* v, const float* gain, int d0, bool rope, int t, float outscale) {
    float ss = 0.f;
#pragma unroll
    for (int j = 0; j < 8; ++j) ss += v[j] * v[j];
    ss += __shfl_xor(ss, 1); ss += __shfl_xor(ss, 2); ss += __shfl_xor(ss, 4);
    const float rstd = rsqrtf(ss * (1.f / 64.f) + 1e-6f);
#pragma unroll
    for (int j = 0; j < 8; ++j) v[j] = v[j] * rstd * gain[d0 + j];
    if (rope) {
#pragma unroll
        for (int p = 0; p < 4; ++p) { const int i = (d0 >> 1) + p; const float pos = (float)(i < 16 ? (t >> 6) : (t & 63));
            const float inv = exp2f(-(float)(i & 15) * (13.287712379549449f / 16.f)); const float ang = pos * inv; const float c = __cosf(ang), s = __sinf(ang);
            const float x1 = v[2 * p], x2 = v[2 * p + 1]; v[2 * p] = x1 * c - x2 * s; v[2 * p + 1] = x1 * s + x2 * c; } }
#pragma unroll
    for (int j = 0; j < 8; ++j) v[j] *= outscale;
}
__device__ __forceinline__ void attn_prep_phase(const bf16_t* PAQ, const bf16_t* PKV, const float* qg, const float* kg, bf16_t* QA, bf16_t* KA, bf16_t* VA) {
    const int tid_ = ltid(), lane = tid_ & 63, bid_ = lbid(), G_ = lgdim(), wv8 = tid_ >> 6;
    int gw, nw, rend;
    if (G_ == 256) { nw = 1;
        if (bid_ < 128) { gw = (bid_ * 8 + wv8) * 9; rend = gw + 9; } else { gw = 9216 + ((bid_ - 128) * 8 + wv8) * 25; rend = gw + 25; } }
    else { gw = bid_ * 8 + wv8; nw = G_ * 8; rend = MT; }
    uint4 nq = make_uint4(0u, 0u, 0u, 0u), nk = nq;
    if (gw < rend) { nq = *(const uint4*)(PAQ + (size_t)gw * 512 + lane * 8); nk = *(const uint4*)(PKV + (size_t)gw * 256 + (lane & 31) * 8); }
    for (int row = gw; row < rend; row += nw) {
        const uint4 rq = nq, raw = nk; const int nrow = row + nw;
        if (nrow < rend) { nq = *(const uint4*)(PAQ + (size_t)nrow * 512 + lane * 8); nk = *(const uint4*)(PKV + (size_t)nrow * 256 + (lane & 31) * 8); }
        const bool lat = row < ML; const int b = lat ? (row >> 12) : ((row - ML) >> 8), t = lat ? (row & 4095) : ((row - ML) & 255);
        const int d0 = (lane & 7) * 8; float v[8];
        unpack8(rq, v);
        norm_rope8(v, qg, d0, lat, t, 0.125f * 1.4426950408889634f);
        *(uint4*)(QA + (size_t)row * 1024 + lane * 8) = pack8(v);
        unpack8(raw, v);
        norm_rope8(v, kg, d0, lat, t, 1.f);
        const size_t kvrow = (size_t)b * KVR + (lat ? CTXL + t : t);
        if (lane < 16) *(uint4*)(KA + kvrow * 128 + lane * 8) = pack8(v);
        else if (lane < 32) *(uint4*)(VA + kvrow * 128 + (lane - 16) * 8) = raw;
    }
}
struct DnBufs { bf16_t* U; bf16_t* W; bf16_t* QK; bf16_t* KT; bf16_t* QN; float* G; };
__device__ __forceinline__ float softplus_f(float x) { const float t = expf(fminf(x, 20.f)); const float sm = t * (1.f - t * (0.5f - t * (0.33333334f - 0.25f * t))); return x > 20.f ? x : (t < 0.0625f ? sm : logf(1.f + t)); }
__device__ __forceinline__ void dn_chunk_phase(const bf16_t* PQKV, const float* BA, const float* cw, const float* alog, const float* dtb, const DnBufs& D, float* ldsf) {
    const int tid = ltid();
    float* K = ldsf; float* V = ldsf + 4352; float* AT = ldsf + 8704; float* beta = ldsf + 16896; float* Gs = beta + 128; float* Q = ldsf + 17152;
    float* KK = ldsf + 21504; float* QKm = ldsf + 25856; float* RAW = ldsf + 21504; float* SOL = ldsf + 17152; float* CWL = ldsf + 35584;
    for (int task = lbid(); task < NB * 4 * NCH; task += lgdim()) {
        const int b = task / (4 * NCH), rem = task % (4 * NCH), h = rem / NCH, tc = rem % NCH;
        int seqbase, L, t0;
        if (tc < 4) { seqbase = ML + b * CTXL; L = CTXL; t0 = tc * 64; } else { seqbase = b * SEQ; L = SEQ; t0 = (tc - 4) * 64; }
        for (int i = tid; i < 68 * 24; i += 512) { const int tt = i / 24, c8 = i % 24, tok = t0 - 2 + tt; float v[8];
            if (tok >= 0 && tok < L) unpack8(*(const uint4*)(PQKV + (size_t)(seqbase + tok) * 768 + (c8 >> 3) * 256 + h * 64 + (c8 & 7) * 8), v);
            else {
#pragma unroll
                for (int j = 0; j < 8; ++j) v[j] = 0.f; }
            *(float4*)(RAW + tt * 192 + c8 * 8) = make_float4(v[0], v[1], v[2], v[3]); *(float4*)(RAW + tt * 192 + c8 * 8 + 4) = make_float4(v[4], v[5], v[6], v[7]); }
        for (int i = tid; i < 960; i += 512) { const int j = i / 192, ch = i % 192; CWL[i] = cw[j * 768 + (ch >> 6) * 256 + h * 64 + (ch & 63)]; }
        __syncthreads();
        for (int i = tid; i < 64 * 192; i += 512) { const int r = i / 192, ch = i % 192, which = ch >> 6, dd = ch & 63; float acc = 0.f;
#pragma unroll
            for (int j = 0; j < 5; ++j) acc += RAW[(r + j) * 192 + ch] * CWL[j * 192 + ch];
            float* dst = which == 0 ? Q : (which == 1 ? K : V);
            dst[r * 68 + dd] = acc * __builtin_amdgcn_rcpf(1.f + __expf(-acc)); }
        __syncthreads();
        { const int row = tid >> 2, part = tid & 3; float* p = (row < 64 ? Q : K) + (row & 63) * 68 + part * 16; float ss = 0.f;
#pragma unroll
          for (int j = 0; j < 16; ++j) ss += p[j] * p[j];
          ss += __shfl_xor(ss, 1); ss += __shfl_xor(ss, 2);
          const float sc = rsqrtf(ss + 1e-6f) * (row < 64 ? 0.125f : 1.f);
#pragma unroll
          for (int j = 0; j < 16; ++j) p[j] *= sc; }
        if (tid < 128) { const int dir = tid >> 6, r = tid & 63, tok = dir ? 63 - r : r; const float* ba = BA + (size_t)(seqbase + t0 + tok) * 16;
            const float bb = 1.f / (1.f + expf(-ba[dir * 4 + h]));
            float gg = -expf(alog[dir * 4 + h]) * softplus_f(ba[8 + dir * 4 + h] + dtb[dir * 4 + h]);
#pragma unroll
            for (int o = 1; o < 64; o <<= 1) { const float up = __shfl_up(gg, o); if (r >= o) gg += up; }
            beta[dir * 64 + r] = bb; Gs[dir * 64 + r] = gg; }
        __syncthreads();
        { typedef float f32x16_t __attribute__((ext_vector_type(16)));
          const int wv = tid >> 6, ln = tid & 63, r32 = ln & 31, hi = ln >> 5, prod = wv >> 2, bi = (wv >> 1) & 1, bj = wv & 1;
          const float* Ar = (prod ? Q : K) + (32 * bi + r32) * 68 + hi; const float* Br = K + (32 * bj + r32) * 68 + hi;
          f32x16_t acc;
#pragma unroll
          for (int r = 0; r < 16; ++r) acc[r] = 0.f;
#pragma unroll 8
          for (int s2 = 0; s2 < 32; ++s2) acc = __builtin_amdgcn_mfma_f32_32x32x2f32(Ar[2 * s2], Br[2 * s2], acc, 0, 0, 0);
          float* dst = (prod ? QKm : KK) + (32 * bi + 4 * hi) * 68 + 32 * bj + r32;
#pragma unroll
          for (int r = 0; r < 16; ++r) dst[((r & 3) + 8 * (r >> 2)) * 68] = acc[r]; }
        __syncthreads();
        const int cid0 = ((0 * NB + b) * 4 + h) * NCH + tc, cid1 = ((1 * NB + b) * 4 + h) * NCH + (tc < 4 ? 3 - tc : 71 - tc);
        for (int idx = tid; idx < 2 * 4096; idx += 512) { const int dir = idx >> 12, rp = (idx >> 6) & 63, r = idx & 63; float v = 0.f;
            if (rp < r) { const int ti = dir ? 63 - r : r, tj = dir ? 63 - rp : rp; v = beta[dir * 64 + r] * KK[ti * 68 + tj] * __expf(Gs[dir * 64 + r] - Gs[dir * 64 + rp]); }
            AT[dir * 4096 + rp * 64 + r] = v; }
        for (int idx = tid; idx < 2 * 64 * 8; idx += 512) { const int dir = idx >> 9, r = (idx >> 3) & 63, p8 = idx & 7; float v[8];
#pragma unroll
            for (int j = 0; j < 8; ++j) { const int rp = unpermk(p8 * 8 + j); v[j] = 0.f;
                if (rp <= r) { const int ti = dir ? 63 - r : r, tj = dir ? 63 - rp : rp; v[j] = QKm[ti * 68 + tj] * __expf(Gs[dir * 64 + r] - Gs[dir * 64 + rp]); } }
            *(uint4*)(D.QK + (size_t)(dir ? cid1 : cid0) * 4096 + r * 64 + p8 * 8) = pack8(v); }
        for (int item = tid; item < 1024; item += 512) { const int dir = item >> 9, dk = (item >> 3) & 63, p8 = item & 7; float v[8];
#pragma unroll
            for (int j = 0; j < 8; ++j) { const int cc = unpermk(p8 * 8 + j), tok = dir ? 63 - cc : cc; v[j] = K[tok * 68 + dk]; }
            *(uint4*)(D.KT + (size_t)(dir ? cid1 : cid0) * 4096 + dk * 64 + p8 * 8) = pack8(v); }
        { const int tok = tid >> 3, p8 = tid & 7; float v[8];
#pragma unroll
          for (int j = 0; j < 8; ++j) v[j] = Q[tok * 68 + unpermk(p8 * 8 + j)];
          *(uint4*)(D.QN + (size_t)(seqbase + t0 + tok) * 256 + h * 64 + p8 * 8) = pack8(v); }
        if (tid < 128) { const int dir = tid >> 6, r = tid & 63; D.G[(size_t)(dir ? cid1 : cid0) * 64 + r] = Gs[dir * 64 + r]; }
        __syncthreads();
        for (int idx = tid; idx < 2 * 64 * 128; idx += 512) { const int dir = idx >> 13, r = (idx >> 7) & 63, c = idx & 127, tok = dir ? 63 - r : r; const float bt = beta[dir * 64 + r];
            SOL[dir * 9216 + r * 144 + c] = c < 64 ? V[tok * 68 + c] * bt : K[tok * 68 + (c - 64)] * bt * __expf(Gs[dir * 64 + r]); }
        __syncthreads();
        { const int col = tid >> 1, hh = tid & 1, dir = col >> 7, c = col & 127; float* S = SOL + dir * 9216 + c; const float* A = AT + dir * 4096;
#pragma unroll 1
            for (int rb = 0; rb < 8; ++rb) { const int r0 = 8 * rb; float a[8];
                if (rb == 2 || rb == 6) {
                    const int ln = tid & 63, i16 = ln & 15, kq = ln >> 4, cb = 32 * ((tid >> 6) & 3), rbase = 8 * rb, kbase = rbase - 16; float* Sd = SOL + dir * 9216 + cb + i16;
#pragma unroll
                    for (int nb = 0; nb < 2; ++nb) { f32x4 acc4 = (f32x4){0.f, 0.f, 0.f, 0.f};
#pragma unroll
                        for (int ks = 0; ks < 4; ++ks) acc4 = __builtin_amdgcn_mfma_f32_16x16x4f32(A[(kbase + 4 * ks + kq) * 64 + rbase + i16], Sd[(kbase + 4 * ks + kq) * 144 + 16 * nb], acc4, 0, 0, 0);
#pragma unroll
                        for (int jj = 0; jj < 4; ++jj) Sd[(rbase + 4 * kq + jj) * 144 + 16 * nb] -= acc4[jj]; } }
                if (rb == 4) {
                    typedef float f32x16_t __attribute__((ext_vector_type(16)));
                    const int ln = tid & 63, r32 = ln & 31, hi2 = ln >> 5, cb = 32 * ((tid >> 6) & 3); float* Sd = SOL + dir * 9216 + cb + r32;
                    f32x16_t acc;
#pragma unroll
                    for (int r = 0; r < 16; ++r) acc[r] = 0.f;
#pragma unroll 8
                    for (int s2 = 0; s2 < 16; ++s2) acc = __builtin_amdgcn_mfma_f32_32x32x2f32(A[(2 * s2 + hi2) * 64 + 32 + r32], Sd[(2 * s2 + hi2) * 144], acc, 0, 0, 0);
#pragma unroll
                    for (int r = 0; r < 16; ++r) Sd[(32 + (r & 3) + 8 * (r >> 2) + 4 * hi2) * 144] -= acc[r]; }
#pragma unroll
                for (int k = 0; k < 8; ++k) a[k] = 0.f;
                for (int j = hh + 16 * (rb >> 1); j < r0; j += 8) {
                    float sv[4]; float4 lo[4], hi[4];
#pragma unroll
                    for (int k = 0; k < 4; ++k) { sv[k] = S[(j + 2 * k) * 144]; lo[k] = *(const float4*)(A + (j + 2 * k) * 64 + r0); hi[k] = *(const float4*)(A + (j + 2 * k) * 64 + r0 + 4); }
#pragma unroll
                    for (int k = 0; k < 4; ++k) { a[0] += lo[k].x * sv[k]; a[1] += lo[k].y * sv[k]; a[2] += lo[k].z * sv[k]; a[3] += lo[k].w * sv[k];
                        a[4] += hi[k].x * sv[k]; a[5] += hi[k].y * sv[k]; a[6] += hi[k].z * sv[k]; a[7] += hi[k].w * sv[k]; } }
                float x[8]; float cf[7][8];
#pragma unroll
                for (int k = 0; k < 8; ++k) x[k] = S[(r0 + k) * 144];
#pragma unroll
                for (int i = 0; i < 7; ++i) { const float4 l4 = *(const float4*)(A + (r0 + i) * 64 + r0), h4 = *(const float4*)(A + (r0 + i) * 64 + r0 + 4);
                    cf[i][0] = l4.x; cf[i][1] = l4.y; cf[i][2] = l4.z; cf[i][3] = l4.w; cf[i][4] = h4.x; cf[i][5] = h4.y; cf[i][6] = h4.z; cf[i][7] = h4.w; }
#pragma unroll
                for (int k = 0; k < 8; ++k) a[k] += __shfl_xor(a[k], 1);
#pragma unroll
                for (int k = 0; k < 8; ++k) { float v = x[k] - a[k];
#pragma unroll
                    for (int i = 0; i < k; ++i) v -= cf[i][k] * x[i];
                    x[k] = v; }
                if (hh == 0) {
#pragma unroll
                    for (int k = 0; k < 8; ++k) S[(r0 + k) * 144] = x[k]; } } }
        __syncthreads();
        for (int item = tid; item < 2048; item += 512) { const int dir = item >> 10, s4 = (item >> 8) & 3, mb = (item >> 6) & 3, q = (item >> 4) & 3, n = item & 15;
            const float* S = SOL + dir * 9216 + (16 * mb + 4 * q) * 144 + 16 * s4 + n; uint2 o; o.x = pk2(S[0], S[144]); o.y = pk2(S[288], S[432]);
            *(uint2*)(D.U + (size_t)(dir ? cid1 : cid0) * 4096 + ((s4 * 4 + mb) * 64 + q * 16 + n) * 4) = o; }
        for (int item = tid; item < 1024; item += 512) { const int dir = item >> 9, r = (item >> 3) & 63, p8 = item & 7; float v[8];
#pragma unroll
            for (int j = 0; j < 8; ++j) v[j] = -SOL[dir * 9216 + r * 144 + 64 + unpermk(p8 * 8 + j)];
            *(uint4*)(D.W + (size_t)(dir ? cid1 : cid0) * 4096 + r * 64 + p8 * 8) = pack8(v); }
        __syncthreads();
    }
}

__device__ __forceinline__ bf16x8 pack_bb(const f32x4 a, const f32x4 b) {
    uint4 r; r.x = pk2(a[0], a[1]); r.y = pk2(a[2], a[3]); r.z = pk2(b[0], b[1]); r.w = pk2(b[2], b[3]); return __builtin_bit_cast(bf16x8, r);
}
#define SCAN_REGION 35328
__device__ __forceinline__ void dn_scan_issue(const DnBufs& D, int dir, int b, int h, int s, int nn, size_t cbase, int lane, PG8_LAS unsigned char* L) {
    const int q = lane >> 4, n = lane & 15;
    const size_t cid = cbase + nn;
    const int tc = dir ? (nn < 4 ? 3 - nn : 71 - nn) : nn;
    const int rowbase = tc < 4 ? ML + b * CTXL + tc * 64 : b * SEQ + (tc - 4) * 64;
    const bf16_t* Wp = D.W + cid * 4096 + n * 64 + q * 8; const bf16_t* QKp = D.QK + cid * 4096 + n * 64 + q * 8; const bf16_t* KTp = D.KT + cid * 4096 + n * 64 + q * 8;
    const bf16_t* Up = D.U + cid * 4096 + (s * 4 * 64 + lane) * 4;
#pragma unroll
    for (int mb = 0; mb < 4; ++mb) {
        const int r = 16 * mb + n; const bf16_t* Np = D.QN + (size_t)(rowbase + (dir ? 63 - r : r)) * 256 + h * 64 + q * 8;
#pragma unroll
        for (int ks = 0; ks < 2; ++ks) { const int f = mb * 2 + ks;
            __builtin_amdgcn_global_load_lds((const unsigned*)(Wp + mb * 1024 + ks * 32), (PG8_LAS unsigned*)(L + f * 1024), 16, 0, 0);
            __builtin_amdgcn_global_load_lds((const unsigned*)(QKp + mb * 1024 + ks * 32), (PG8_LAS unsigned*)(L + 8192 + f * 1024), 16, 0, 0);
            __builtin_amdgcn_global_load_lds((const unsigned*)(KTp + mb * 1024 + ks * 32), (PG8_LAS unsigned*)(L + 16384 + f * 1024), 16, 0, 0);
            __builtin_amdgcn_global_load_lds((const unsigned*)(Np + ks * 32), (PG8_LAS unsigned*)(L + 24576 + f * 1024), 16, 0, 0); }
        __builtin_amdgcn_global_load_lds((const unsigned*)(Up + mb * 256), (PG8_LAS unsigned*)(L + 32768 + (mb * 2) * 256), 4, 0, 0);
        __builtin_amdgcn_global_load_lds((const unsigned*)(Up + mb * 256 + 2), (PG8_LAS unsigned*)(L + 32768 + (mb * 2 + 1) * 256), 4, 0, 0); }
    __builtin_amdgcn_global_load_lds((const unsigned*)(D.G + cid * 64 + lane), (PG8_LAS unsigned*)(L + 34816), 4, 0, 0);
}
__device__ __forceinline__ void dn_scan_chain(const DnBufs& D, float* OF, float* OB, int chain, int lane, PG8_LAS unsigned char* L) {
    const int dir = chain >> 7, b = (chain >> 4) & 7, h = (chain >> 2) & 3, s = chain & 3, q = lane >> 4, n = lane & 15;
    float* O = dir ? OB : OF;
    f32x4 S[4];
#pragma unroll
    for (int i = 0; i < 4; ++i) S[i] = (f32x4){0.f, 0.f, 0.f, 0.f};
    const size_t cbase = (size_t)((dir * NB + b) * 4 + h) * NCH;
    dn_scan_issue(D, dir, b, h, s, 0, cbase, lane, L);
    for (int nn = 0; nn < NCH; ++nn) {
        const int tc = dir ? (nn < 4 ? 3 - nn : 71 - nn) : nn;
        const int rowbase = tc < 4 ? ML + b * CTXL + tc * 64 : b * SEQ + (tc - 4) * 64;
        asm volatile("s_waitcnt vmcnt(0)" ::: "memory");
        bf16x8 wf[4][2], qf[4][2], kf[4][2], nf[4][2]; f32x4 vn[4], g4[4];
#pragma unroll
        for (int mb = 0; mb < 4; ++mb) {
#pragma unroll
            for (int ks = 0; ks < 2; ++ks) { const int f = mb * 2 + ks;
                wf[mb][ks] = *(const PG8_LAS bf16x8*)(L + f * 1024 + lane * 16); qf[mb][ks] = *(const PG8_LAS bf16x8*)(L + 8192 + f * 1024 + lane * 16);
                kf[mb][ks] = *(const PG8_LAS bf16x8*)(L + 16384 + f * 1024 + lane * 16); nf[mb][ks] = *(const PG8_LAS bf16x8*)(L + 24576 + f * 1024 + lane * 16); }
            const unsigned u0 = *(const PG8_LAS unsigned*)(L + 32768 + (mb * 2) * 256 + lane * 4), u1 = *(const PG8_LAS unsigned*)(L + 32768 + (mb * 2 + 1) * 256 + lane * 4);
            vn[mb] = (f32x4){__uint_as_float(u0 << 16), __uint_as_float(u0 & 0xffff0000u), __uint_as_float(u1 << 16), __uint_as_float(u1 & 0xffff0000u)};
            g4[mb] = *(const PG8_LAS f32x4*)(L + 34816 + (16 * mb + 4 * q) * 4); }
        const float glast = *(const PG8_LAS float*)(L + 34816 + 63 * 4);
        asm volatile("s_waitcnt lgkmcnt(0)" ::: "memory");
        bf16x8 Sb[2] = {pack_bb(S[0], S[1]), pack_bb(S[2], S[3])};
        f32x4 o1[4], o2[4];
#pragma unroll
        for (int mb = 0; mb < 4; ++mb) {
            vn[mb] = __builtin_amdgcn_mfma_f32_16x16x32_bf16(wf[mb][0], Sb[0], vn[mb], 0, 0, 0); vn[mb] = __builtin_amdgcn_mfma_f32_16x16x32_bf16(wf[mb][1], Sb[1], vn[mb], 0, 0, 0);
            o1[mb] = __builtin_amdgcn_mfma_f32_16x16x32_bf16(nf[mb][0], Sb[0], (f32x4){0.f, 0.f, 0.f, 0.f}, 0, 0, 0); o1[mb] = __builtin_amdgcn_mfma_f32_16x16x32_bf16(nf[mb][1], Sb[1], o1[mb], 0, 0, 0); }
        __builtin_amdgcn_sched_barrier(0);
        if (nn + 1 < NCH) dn_scan_issue(D, dir, b, h, s, nn + 1, cbase, lane, L);
        __builtin_amdgcn_sched_barrier(0);
        bf16x8 Vb[2] = {pack_bb(vn[0], vn[1]), pack_bb(vn[2], vn[3])};
        f32x4 e[4];
#pragma unroll
        for (int mb = 0; mb < 4; ++mb)
#pragma unroll
            for (int j = 0; j < 4; ++j) e[mb][j] = __expf(glast - g4[mb][j]);
        bf16x8 Vs[2] = {pack_bb(vn[0] * e[0], vn[1] * e[1]), pack_bb(vn[2] * e[2], vn[3] * e[3])};
        const float gl = __expf(glast);
#pragma unroll
        for (int mb = 0; mb < 4; ++mb) {
            o2[mb] = __builtin_amdgcn_mfma_f32_16x16x32_bf16(qf[mb][0], Vb[0], (f32x4){0.f, 0.f, 0.f, 0.f}, 0, 0, 0); o2[mb] = __builtin_amdgcn_mfma_f32_16x16x32_bf16(qf[mb][1], Vb[1], o2[mb], 0, 0, 0);
            S[mb] = S[mb] * gl; S[mb] = __builtin_amdgcn_mfma_f32_16x16x32_bf16(kf[mb][0], Vs[0], S[mb], 0, 0, 0); S[mb] = __builtin_amdgcn_mfma_f32_16x16x32_bf16(kf[mb][1], Vs[1], S[mb], 0, 0, 0); }
#pragma unroll
        for (int mb = 0; mb < 4; ++mb)
#pragma unroll
            for (int j = 0; j < 4; ++j) { const int r = 16 * mb + 4 * q + j;
                O[(size_t)(rowbase + (dir ? 63 - r : r)) * 256 + h * 64 + s * 16 + n] = __expf(g4[mb][j]) * o1[mb][j] + o2[mb][j]; }
    }
    asm volatile("s_waitcnt vmcnt(0)" ::: "memory");
}

__device__ __forceinline__ void dn_out_phase(const float* OF, const float* OB, const bf16_t* PZ, const float* gn, bf16_t* YD) {
    const int tid_ = ltid(), lane = tid_ & 63, gw = lbid() * 8 + (tid_ >> 6), nw = lgdim() * 8;
    const float4 g = *(const float4*)(gn + (lane & 15) * 4);
    float4 na = make_float4(0.f, 0.f, 0.f, 0.f), nb = na; uint2 nz = make_uint2(0u, 0u);
    if (gw < MT) { na = *(const float4*)(OF + (size_t)gw * 256 + lane * 4); nb = *(const float4*)(OB + (size_t)gw * 256 + lane * 4); nz = *(const uint2*)(PZ + (size_t)gw * 256 + lane * 4); }
    for (int row = gw; row < MT; row += nw) {
        const float4 a = na, bq = nb; const uint2 zz = nz; const int nrow = row + nw;
        if (nrow < MT) { na = *(const float4*)(OF + (size_t)nrow * 256 + lane * 4); nb = *(const float4*)(OB + (size_t)nrow * 256 + lane * 4); nz = *(const uint2*)(PZ + (size_t)nrow * 256 + lane * 4); }
#ifdef PROBE_O1
        const float o0 = 1.f + 0.f * (a.x + bq.x), o1 = 1.f, o2 = 1.f, o3 = 1.f;
#else
        const float o0 = a.x + bq.x, o1 = a.y + bq.y, o2 = a.z + bq.z, o3 = a.w + bq.w;
#endif
        float ss = o0 * o0 + o1 * o1 + o2 * o2 + o3 * o3;
        ss += __shfl_xor(ss, 1); ss += __shfl_xor(ss, 2); ss += __shfl_xor(ss, 4); ss += __shfl_xor(ss, 8);
        const float rstd = rsqrtf(ss * (1.f / 64.f) + 1e-6f);
        const float z0 = __uint_as_float(zz.x << 16), z1 = __uint_as_float(zz.x & 0xffff0000u), z2 = __uint_as_float(zz.y << 16), z3 = __uint_as_float(zz.y & 0xffff0000u);
        uint2 o; o.x = pk2(o0 * rstd * g.x * pg8::fsilu(z0), o1 * rstd * g.y * pg8::fsilu(z1)); o.y = pk2(o2 * rstd * g.z * pg8::fsilu(z2), o3 * rstd * g.w * pg8::fsilu(z3));
        *(uint2*)(YD + (size_t)row * 1024 + lane * 4) = o;
    }
}

#define XB_TMO      128
#define XB_XCNT(j)  (256  + 64 * (j))
#define XB_XSUB(j)  (1280 + 64 * (j))
#define XB_XGEN(j)  (2304 + 64 * (j))
#define XB_TOP      3328
#define XB_TOPGEN   3392
#define XCD_BAR_WORDS 3456
#define XB_SPIN_CAP (1u << 18)
#define XLAS __attribute__((address_space(3)))

__device__ __forceinline__ unsigned xb_ld(unsigned* p)              { return __hip_atomic_load(p, __ATOMIC_RELAXED, __HIP_MEMORY_SCOPE_AGENT); }
__device__ __forceinline__ unsigned xb_add(unsigned* p, unsigned v) { return __hip_atomic_fetch_add(p, v, __ATOMIC_RELAXED, __HIP_MEMORY_SCOPE_AGENT); }
__device__ __forceinline__ unsigned xb_xcc_id() { return (unsigned)__builtin_amdgcn_s_getreg((3 << 11) | 20) & 0xFu; }
#define XB_SPIN(cond, bar) do { unsigned _sp = 0; while (cond) { __builtin_amdgcn_s_sleep(1); \
    if ((++_sp & 255u) == 0u) { if (xb_ld(&(bar)[XB_TMO])) break; if (_sp > XB_SPIN_CAP) { atomicAdd(&(bar)[XB_TMO], 1u); break; } } } } while (0)

struct XcdBarrier {
    unsigned* bar; unsigned x;
    volatile XLAS unsigned* st;
};

__device__ __forceinline__ XcdBarrier xcd_barrier_post(unsigned* bar, volatile XLAS unsigned* st) {
    XcdBarrier b; b.bar = bar; b.x = xb_xcc_id(); b.st = st;
    if (threadIdx.x == 0) (void)xb_add(&bar[XB_XCNT(b.x)], 1u);
    return b;
}
__device__ __forceinline__ void xcd_barrier_complete(unsigned* bar, unsigned x, unsigned& nloc, unsigned& nx) {
    const unsigned G = gridDim.x * gridDim.y * gridDim.z;
    unsigned sum, cnt, mine, sp = 0u;
    for (;;) {
        sum = 0u; cnt = 0u; mine = 0u;
#pragma unroll
        for (unsigned j = 0; j < 16; ++j) { const unsigned c = xb_ld(&bar[XB_XCNT(j)]); sum += c; cnt += (c > 0u) ? 1u : 0u; mine = (j == x) ? c : mine; }
        if (sum == G) break;
        __builtin_amdgcn_s_sleep(1);
        if ((++sp & 255u) == 0u) { if (xb_ld(&bar[XB_TMO])) break; if (sp > XB_SPIN_CAP) { atomicAdd(&bar[XB_TMO], 1u); break; } }
    }
    nloc = mine > 0u ? mine : 1u; nx = cnt > 0u ? cnt : 1u;
}

__device__ __forceinline__ void xcd_barrier(const XcdBarrier& b) {
    asm volatile("s_waitcnt vmcnt(0)" ::: "memory");
    __syncthreads();
    if (threadIdx.x == 0) {
        unsigned* bar = b.bar;
        __builtin_amdgcn_s_waitcnt(0);
        unsigned nloc = b.st[0], nx = b.st[1];
        if (nloc == 0u) { xcd_barrier_complete(bar, b.x, nloc, nx); b.st[0] = nloc; b.st[1] = nx; }
        const unsigned old = xb_add(&bar[XB_XSUB(b.x)], 1u);
        const unsigned gen = old / nloc;
        if (old + 1u == (gen + 1u) * nloc) {
            __builtin_amdgcn_fence(__ATOMIC_RELEASE, "agent");
            asm volatile("s_waitcnt vmcnt(0)" ::: "memory");
            const unsigned og = xb_add(&bar[XB_TOP], 1u);
            const unsigned tg = og / nx;
            if (og + 1u == (tg + 1u) * nx) xb_add(&bar[XB_TOPGEN], 1u);
            else XB_SPIN(xb_ld(&bar[XB_TOPGEN]) == tg, bar);
            __builtin_amdgcn_fence(__ATOMIC_ACQUIRE, "agent");
            xb_add(&bar[XB_XGEN(b.x)], 1u);
            asm volatile("s_waitcnt vmcnt(0)" ::: "memory");
        } else {
            XB_SPIN(xb_ld(&bar[XB_XGEN(b.x)]) == gen, bar);
            __builtin_amdgcn_fence(__ATOMIC_ACQUIRE, "agent");
            asm volatile("s_waitcnt vmcnt(0)" ::: "memory");
        }
    }
    __syncthreads();
}

__global__ void __launch_bounds__(512, 2) fwd_mega(Args a) {
    extern __shared__ __attribute__((aligned(16))) unsigned char lds[];
    cg::grid_group grid = cg::this_grid();
    float* ldsf = (float*)lds;
    unsigned char* ws = a.ws;
    float* MOD = (float*)(ws + WS_MOD); float* XC = (float*)(ws + WS_XC); bf16_t* H = (bf16_t*)(ws + WS_H);
    bf16_t* ACT = (bf16_t*)(ws + WS_ACT); float* PART = (float*)(ws + WS_DNU);
    volatile XLAS unsigned* xst = (volatile XLAS unsigned*)((XLAS unsigned char*)lds + 146432);
    if (threadIdx.x == 0) { xst[0] = 0u; xst[1] = 0u; }
    __syncthreads();
    (void)xcd_barrier_post((unsigned*)(ws + WS_BAR), xst);
#define GSYNC() do { XcdBarrier xb_; xb_.bar = (unsigned*)(ws + WS_BAR); xb_.x = xb_xcc_id(); xb_.st = xst; xcd_barrier(xb_); } while (0)
    for (size_t i = (size_t)blockIdx.x * 512 + threadIdx.x; i < (size_t)MC * DM / 4; i += (size_t)gridDim.x * 512) ((float4*)XC)[i] = ((const float4*)a.in[I_CTX])[i];
    mods_phase(a, ldsf, MOD);
    weights_phase(a, 0, ws, ldsf, true, gridDim.x != 256);
    if (a.ws == nullptr) grid.sync();
    GSYNC();
    for (int l = 0; l < DEPTH; ++l) {
        const int G = lgdim(), bid = lbid();
        const float* xl_in = l == 0 ? a.in[I_X] : a.out; const float* xc_in = l == 0 ? a.in[I_CTX] : XC;
        const float* modl = MOD + (size_t)l * 9 * MODW;
        if (l > 0) weights_phase(a, l, ws, ldsf, G != 256, G != 256 || l == DEPTH - 1);
        norm_phase(xl_in, xc_in, a.in[I_NF1] + l * 1024, modl, 0, H, MT, XC, PART, l > 0 ? 8 : 0);
        GSYNC();
        { pg8::Gemm g{H, (const bf16_t*)(ws + WS_W1IN), MT, 5632, 1024}; pg8::StaticOrder S; S.init(MT, 5632, G, bid); pg8::EpiSwiglu E{ACT};
          pg8::gemm_phase<pg8::EpiSwiglu, pg8::StaticOrder, true, true>((PG8_LAS unsigned char*)lds, g, S, E); }
        GSYNC();
        { pg8::Gemm g{ACT, (const bf16_t*)(ws + WS_W1OUT), MT, 1024, 2816}; pg8::SplitOrder S; S.init(ML, MT, 1024, 2816, G, bid, 8); pg8::EpiResid E{xl_in, a.out, XC, modl + 2 * 1024, PART, 0.5f};
          pg8::gemm_phase<pg8::EpiResid, pg8::SplitOrder, true, true>((PG8_LAS unsigned char*)lds, g, S, E); }
        GSYNC();
        norm_phase(a.out, XC, a.in[I_NMIX] + l * 1024, modl, 3, H, MT, XC, PART, 8);
        GSYNC();
        { pg8::Gemm g{H, (const bf16_t*)(ws + WS_WIN), MT, 5120, 1024}; pg8::StaticOrder S; S.init(MT, 5120, G, bid);
          pg8::EpiProj E{(bf16_t*)(ws + WS_PPOOL), (bf16_t*)(ws + WS_PQKV), (bf16_t*)(ws + WS_PZ), (bf16_t*)(ws + WS_PAQ), (bf16_t*)(ws + WS_PKV), (bf16_t*)(ws + WS_PGATE)};
          pg8::gemm_phase<pg8::EpiProj, pg8::StaticOrder, true, true>((PG8_LAS unsigned char*)lds, g, S, E); }
        if constexpr (EN_MASK & 2) ba_phase(a.in[I_WIN] + (size_t)l * 1024 * INC, H, (float*)(ws + WS_BA), ldsf);
        GSYNC();
        const DnBufs D{(bf16_t*)(ws + WS_DNU), (bf16_t*)(ws + WS_DNW), (bf16_t*)(ws + WS_DNQK), (bf16_t*)(ws + WS_DNKT), (bf16_t*)(ws + WS_DNQN), (float*)(ws + WS_DNG)};
        for (int rep_ = 0; rep_ < DBL_CHUNK; ++rep_) dn_chunk_phase((const bf16_t*)(ws + WS_PQKV), (const float*)(ws + WS_BA), a.in[I_CONV] + l * 5 * 768, a.in[I_ALOG] + l * 8, a.in[I_DTB] + l * 8, D, ldsf);
        if constexpr (EN_MASK & 16) attn_prep_phase((const bf16_t*)(ws + WS_PAQ), (const bf16_t*)(ws + WS_PKV), a.in[I_QN] + l * 64, a.in[I_KN] + l * 64, (bf16_t*)(ws + WS_Y) + 512, (bf16_t*)(ws + WS_KATT), (bf16_t*)(ws + WS_VATT));
        GSYNC();
        { using abf = attn_body::bf16; abf* QA = (abf*)(ws + WS_Y) + 512; const abf* KA = (const abf*)(ws + WS_KATT); const abf* VA = (const abf*)(ws + WS_VATT);
          const int t_ = ltid(), wv_ = __builtin_amdgcn_readfirstlane(t_ >> 6);
          if (wv_ < 4) for (int chain = bid * 4 + wv_; chain < 256; chain += G * 4) dn_scan_chain(D, (float*)(ws + WS_OF), (float*)(ws + WS_OB), chain, t_ & 63, (PG8_LAS unsigned char*)lds + wv_ * SCAN_REGION);
          unsigned* ctr = (unsigned*)(ws + WS_CTR) + l; volatile unsigned* slot = (volatile unsigned*)(ldsf + 36600);
          const int natt = (l == DEPTH - 1) ? 1024 : 1024 + 64, npool = ((l == DEPTH - 1) ? 512 : 544) * 4; bool wres = false;
          for (;;) {
              __syncthreads();
              if (t_ == 0) *slot = atomicAdd(ctr, 1u);
              __syncthreads();
              const int id = (int)__builtin_amdgcn_readfirstlane(*slot);
              if (id >= natt + npool) break;
              if (id >= natt) {
                  if (!wres) { pool_load_w(a.in[I_POOLW] + (size_t)l * 4 * 4096, ldsf, t_); wres = true; }
                  pool_task((const bf16_t*)(ws + WS_PPOOL), a.in[I_POOLS] + l * 256, (bf16_t*)(ws + WS_Y), ldsf, id - natt, t_);
                  continue; }
              int b, h, NT; abf* Qu;
              if (id < 1024) { b = id >> 7; h = (id >> 4) & 7; Qu = QA + ((size_t)b * SEQ + (id & 15) * 256) * 1024 + h * 64; NT = KVR / 64; }
              else { const int c = id - 1024; b = c >> 3; h = c & 7; Qu = QA + ((size_t)ML + b * CTXL) * 1024 + h * 64; NT = CTXL / 64; }
              attn_body::attn_unit<8>(Qu, KA + (size_t)b * KVR * 128 + (h >> 2) * 64, VA + (size_t)b * KVR * 128 + (h >> 2) * 64, Qu, NT, (char*)lds); } }
        GSYNC();
        if constexpr (EN_MASK & 128) dn_out_phase((const float*)(ws + WS_OF), (const float*)(ws + WS_OB), (const bf16_t*)(ws + WS_PZ), a.in[I_DNN] + l * 64, (bf16_t*)(ws + WS_Y) + 256);
        GSYNC();
        const int MR = (l == DEPTH - 1) ? ML : MT;
        for (int rep_ = 0; rep_ < DBL_MERGE; ++rep_) { pg8::Gemm g{(const bf16_t*)(ws + WS_Y), (const bf16_t*)(ws + WS_WA), MR, 1024, 1024}; pg8::MergeOrder S; S.init(MR, 1024, G, bid);
          pg8::EpiGate E{(const bf16_t*)(ws + WS_PGATE), (bf16_t*)(ws + WS_MBF)};
          pg8::gemm_phase<pg8::EpiGate, pg8::MergeOrder, true, true>((PG8_LAS unsigned char*)lds, g, S, E); }
        if (G == 256 && l < DEPTH - 1 && bid >= 32) {
            const int t_ = ltid(), ln = l + 1;
            for (int t = bid - 32; t < 3392 + 2112; t += 224) {
                if (t < 1408) tconv_tile(a.in[I_F1IN] + (size_t)ln * 1024 * 5632, 5632, 1024, 1, (bf16_t*)(ws + WS_W1IN), t, ldsf, t_);
                else if (t < 2112) tconv_tile(a.in[I_F1OUT] + (size_t)ln * 2816 * 1024, 1024, 2816, 0, (bf16_t*)(ws + WS_W1OUT), t - 1408, ldsf, t_);
                else if (t < 3392) tconv_tile(a.in[I_WIN] + (size_t)ln * 1024 * INC, INC, 1024, 2, (bf16_t*)(ws + WS_WIN), t - 2112, ldsf, t_);
                else if (t < 4800) tconv_tile(a.in[I_F2IN] + (size_t)l * 1024 * 5632, 5632, 1024, 1, (bf16_t*)(ws + WS_W2IN), t - 3392, ldsf, t_);
                else tconv_tile(a.in[I_F2OUT] + (size_t)l * 2816 * 1024, 1024, 2816, 0, (bf16_t*)(ws + WS_W2OUT), t - 4800, ldsf, t_); } }
        GSYNC();
        { pg8::Gemm g{(const bf16_t*)(ws + WS_MBF), (const bf16_t*)(ws + WS_WOUT), MR, 1024, 1024}; pg8::SplitOrder S; S.init(ML, MR, 1024, 1024, G, bid, 4); pg8::EpiResid E{a.out, a.out, XC, modl + 5 * 1024, PART, 1.0f};
          pg8::gemm_phase<pg8::EpiResid, pg8::SplitOrder, true, true>((PG8_LAS unsigned char*)lds, g, S, E); }
        GSYNC();
        norm_phase(a.out, XC, a.in[I_NF2] + l * 1024, modl, 6, H, MR, XC, PART, 4);
        GSYNC();
        { pg8::Gemm g{H, (const bf16_t*)(ws + WS_W2IN), MR, 5632, 1024}; pg8::StaticOrder S; S.init(MR, 5632, G, bid); pg8::EpiSwiglu E{ACT};
          pg8::gemm_phase<pg8::EpiSwiglu, pg8::StaticOrder, true, true>((PG8_LAS unsigned char*)lds, g, S, E); }
        GSYNC();
        { pg8::Gemm g{ACT, (const bf16_t*)(ws + WS_W2OUT), MR, 1024, 2816}; pg8::SplitOrder S; S.init(ML, MR, 1024, 2816, G, bid, 8); pg8::EpiResid E{a.out, a.out, XC, modl + 8 * 1024, PART, 0.5f};
          pg8::gemm_phase<pg8::EpiResid, pg8::SplitOrder, true, true>((PG8_LAS unsigned char*)lds, g, S, E); }
        GSYNC();
    }
    final_norm_phase(a.out, a.in[I_NFIN]);
}

extern "C" void kernel_launch(void* const* d_in, const int* in_sizes, int n_in, void* d_out, int out_size, void* d_ws, size_t ws_size, hipStream_t stream) {
    static int grid = 0;
    if (grid == 0) {
        if (n_in != 25 || out_size != ML * DM || ws_size < WS_END) { fprintf(stderr, "kernel_launch: unexpected shapes: n_in %d out %d ws %zu (need %zu)\n", n_in, out_size, ws_size, (size_t)WS_END); grid = -1; return; }
        int dev = 0, cus = 0, per_cu = 0;
        hipGetDevice(&dev); hipDeviceGetAttribute(&cus, hipDeviceAttributeMultiprocessorCount, dev);
        if (hipFuncSetAttribute((const void*)fwd_mega, hipFuncAttributeMaxDynamicSharedMemorySize, LDS_BYTES) != hipSuccess) { fprintf(stderr, "kernel_launch: hipFuncSetAttribute failed\n"); grid = -1; return; }
        hipOccupancyMaxActiveBlocksPerMultiprocessor(&per_cu, (const void*)fwd_mega, 512, LDS_BYTES);
        (void)hipGetLastError();
        fprintf(stderr, "kernel_launch: cus %d per_cu %d ws %zu\n", cus, per_cu, ws_size);
        grid = cus * (per_cu >= 1 ? 1 : 1);
    }
    if (grid < 0) return;
    Args a{};
    for (int i = 0; i < 25; ++i) a.in[i] = (const float*)d_in[i];
    a.out = (float*)d_out; a.ws = (unsigned char*)d_ws;
    if (hipMemsetAsync((unsigned char*)d_ws + WS_CTR, 0, WS_CTL_BYTES, stream) != hipSuccess) { fprintf(stderr, "kernel_launch: memset of the control words failed\n"); return; }
    void* args[] = {&a};
    hipError_t e = hipLaunchCooperativeKernel((void*)fwd_mega, dim3(grid), dim3(512), args, LDS_BYTES, stream);
    if (e != hipSuccess) fprintf(stderr, "kernel_launch: cooperative launch failed: %s (grid %d)\n", hipGetErrorString(e), grid);
}
```

```cpp
#include <hip/hip_runtime.h>
#include <hip/hip_cooperative_groups.h>
#include <cstdio>
#include <cstdint>
namespace cg = cooperative_groups;
#ifndef DBL_SCAN
#define DBL_SCAN 1
#endif
#ifndef DBL_CHUNK
#define DBL_CHUNK 1
#endif
#ifndef DBL_MERGE
#define DBL_MERGE 1
#endif
#ifndef ABL
#define ABL 0
#define PROBE_SCAN1 0
#endif
#ifndef EN_MASK
#define EN_MASK 0xFFFF
#endif

__device__ __forceinline__ int ltid() { int t = threadIdx.x; asm volatile("" : "+v"(t)); return t; }
__device__ __forceinline__ int lbid() { int t = blockIdx.x; asm volatile("" : "+s"(t)); return t; }
__device__ __forceinline__ int lgdim() { int t = gridDim.x; asm volatile("" : "+s"(t)); return t; }
namespace pg8 {
#define PG8_LAS __attribute__((address_space(3)))
typedef unsigned short bf16_t;
typedef short bf16x8 __attribute__((ext_vector_type(8)));
typedef float f32x4 __attribute__((ext_vector_type(4)));
typedef unsigned u32x4 __attribute__((ext_vector_type(4)));
constexpr int BM = 256, BK = 64, HALF = 128, HTB = HALF * BK * 2  , STAGE_BYTES = 8 * HTB, NXCD = 8, WGM = 4;

__host__ __device__ __forceinline__ int lds_byte(int r, int c) { const int st = (r >> 4) * 2 + (c >> 5), rr = r & 15, cc = c & 31, ob = rr * 64 + cc * 2; return st * 1024 + (ob ^ (((ob >> 9) & 1) << 5)); }
__host__ __device__ __forceinline__ void stage_rc(int b, int& R, int& C) { const int st = b / 1024, sb = b % 1024, swz = sb ^ (((sb >> 9) & 1) << 5); R = (st >> 1) * 16 + swz / 64; C = (st & 1) * 32 + (swz % 64) / 2; }
__host__ __device__ __forceinline__ int perm32(int rho) { const int n = rho >> 4, i = rho & 15; return 8 * (i >> 2) + 4 * n + (i & 3); }

struct Unit { int pm, pn, k0, nt, part; };
struct Gemm { const bf16_t* A; const bf16_t* Bt; int M, N, K; };

struct StaticOrder {
    int nM, nN, nwg, G, c;
    __host__ __device__ __forceinline__ void init(int M, int N, int G_, int c_) { nM = M / BM; nN = N / BM; nwg = nM * nN; G = G_; c = c_; }
    __host__ __device__ __forceinline__ bool next(int i, Unit& u) const {
        const long L = (long)i * G + c; if (L >= nwg) return false;
        int wgid = (int)L; { const int q = nwg / NXCD, r = nwg % NXCD, xcd = wgid % NXCD, off = wgid / NXCD; wgid = (xcd < r ? xcd * (q + 1) : r * (q + 1) + (xcd - r) * q) + off; }
        const int nig = WGM * nN, gid = wgid / nig, fm = gid * WGM, gsz = (nM - fm) < WGM ? (nM - fm) : WGM;
        u.pm = fm + ((wgid % nig) % gsz); u.pn = (wgid % nig) / gsz; u.k0 = 0; u.nt = 0; u.part = 0; return true;
    }
    __device__ __forceinline__ void a_ready(const Unit&) const {}
    __device__ __forceinline__ void done(const Unit&) const {}
};
struct MergeOrder {
    StaticOrder F;
    __host__ __device__ __forceinline__ void init(int M, int N, int G_, int c_) { F.init(M, N, G_, c_); }
    __host__ __device__ __forceinline__ bool next(int i, Unit& u) const {
        const int it = i / 3, br = i - 3 * it; int wgid = it * F.G + F.c; const bool valid = wgid < F.nwg; wgid = valid ? wgid : F.nwg - 1;
        { const int qq = F.nwg / NXCD, rr = F.nwg % NXCD, xcd = wgid % NXCD, off = wgid / NXCD; wgid = (xcd < rr ? xcd * (qq + 1) : rr * (qq + 1) + (xcd - rr) * qq) + off; }
        const int nig = WGM * F.nN, gid = wgid / nig, fm = gid * WGM, gsz = (F.nM - fm) < WGM ? (F.nM - fm) : WGM;
        u.pm = fm + ((wgid % nig) % gsz); u.pn = (wgid % nig) / gsz; u.k0 = br == 0 ? 0 : (br == 1 ? 4 : 8); u.nt = br == 2 ? 8 : 4; u.part = br;
        return valid;
    }
    __device__ __forceinline__ void a_ready(const Unit&) const {}
    __device__ __forceinline__ void done(const Unit&) const {}
};
struct SplitOrder {
    StaticOrder F; int nf, G, c, pm0, nN, ntail, parts, q, r;
    __host__ __device__ __forceinline__ void init(int MF, int MTOT, int N, int K, int G_, int c_, int parts_) {
        F.init(MF, N, G_, c_); G = G_; c = c_; nf = c < F.nwg ? (F.nwg - c + G - 1) / G : 0; pm0 = MF / BM; nN = N / BM; parts = parts_; ntail = ((MTOT - MF) / BM) * nN * parts;
        const int pairs = K / (2 * BK); q = pairs / parts; r = pairs % parts; }
    __host__ __device__ __forceinline__ bool next(int i, Unit& u) const {
        const bool full = i < nf;
        int wgid = i * G + c; wgid = wgid < F.nwg ? wgid : F.nwg - 1;
        { const int qq = F.nwg / NXCD, rr = F.nwg % NXCD, xcd = wgid % NXCD, off = wgid / NXCD; wgid = (xcd < rr ? xcd * (qq + 1) : rr * (qq + 1) + (xcd - rr) * qq) + off; }
        const int nig = WGM * F.nN, gid = wgid / nig, fm = gid * WGM, gsz = (F.nM - fm) < WGM ? (F.nM - fm) : WGM;
        const int fpm = fm + ((wgid % nig) % gsz), fpn = (wgid % nig) / gsz;
        const int j = (i - nf) * G + c, tile = j / parts, p = j % parts;
        u.pm = full ? fpm : pm0 + tile / nN; u.pn = full ? fpn : tile % nN; u.nt = full ? 0 : 2 * (q + (p < r ? 1 : 0)); u.k0 = full ? 0 : 2 * (p * q + (p < r ? p : r)); u.part = full ? 0 : p;
        return full || j < ntail;
    }
    __device__ __forceinline__ void a_ready(const Unit&) const {}
    __device__ __forceinline__ void done(const Unit&) const {}
};
__device__ __forceinline__ unsigned cvt_pk_bf16(float lo, float hi) { unsigned r; asm volatile("v_cvt_pk_bf16_f32 %0, %1, %2" : "=v"(r) : "v"(lo), "v"(hi)); return r; }
constexpr int XML = 32768;
__device__ __forceinline__ float fsilu(float x) { return x * __builtin_amdgcn_rcpf(1.f + __expf(-x)); }
__device__ __forceinline__ float fsigm(float x) { return __builtin_amdgcn_rcpf(1.f + __expf(-x)); }
struct EpiSwiglu {
    static constexpr bool PERM = true, AFTER_DRAIN = false, KEEP_ACC = false;
    bf16_t* O;
    __device__ __forceinline__ void operator()(const f32x4 (&acc)[2][2][4][2], const Unit& u, int wr, int wc, int fr, int fq) const {
        const int row0 = u.pm * BM + wr * 64 + fr, col0 = u.pn * 128 + wc * 32 + 8 * fq;
#pragma unroll
        for (int ai = 0; ai < 2; ++ai)
#pragma unroll
            for (int m = 0; m < 4; ++m) { bf16_t* rowp = O + (size_t)(row0 + ai * HALF + m * 16) * 2816 + col0;
                const f32x4 g0 = acc[ai][0][m][0], g1 = acc[ai][0][m][1], u0 = acc[ai][1][m][0], u1 = acc[ai][1][m][1];
                u32x4 w; w.x = cvt_pk_bf16(fsilu(g0[0]) * u0[0], fsilu(g0[1]) * u0[1]); w.y = cvt_pk_bf16(fsilu(g0[2]) * u0[2], fsilu(g0[3]) * u0[3]);
                w.z = cvt_pk_bf16(fsilu(g1[0]) * u1[0], fsilu(g1[1]) * u1[1]); w.w = cvt_pk_bf16(fsilu(g1[2]) * u1[2], fsilu(g1[3]) * u1[3]);
                *(u32x4*)rowp = w; }
    }
};
struct EpiResid {
    static constexpr bool PERM = false, AFTER_DRAIN = false, KEEP_ACC = false;
    const float* xin_l; float* xo_l; float* xc; const float* gate; float* part; float coef;
    __device__ __forceinline__ void operator()(const f32x4 (&acc)[2][2][4][2], const Unit& u, int wr, int wc, int fr, int fq) const {
        const int row0 = u.pm * BM + wr * 64 + fr, col0 = u.pn * BM + wc * 32 + 4 * fq;
        const bool lat = u.pm * BM < XML;
        const float* gp = gate + (size_t)(lat ? ((u.pm * BM) >> 12) : 8) * 9216 + col0;
        f32x4 gv[2][2];
#pragma unroll
        for (int bj = 0; bj < 2; ++bj)
#pragma unroll
            for (int n = 0; n < 2; ++n) gv[bj][n] = *(const f32x4*)(gp + bj * HALF + n * 16) * coef;
        if (u.nt) {
#pragma unroll
            for (int ai = 0; ai < 2; ++ai)
#pragma unroll
                for (int m = 0; m < 4; ++m) { float* pp = part + ((size_t)u.part * 2048 + (row0 + ai * HALF + m * 16 - XML)) * 1024 + col0;
#pragma unroll
                    for (int bj = 0; bj < 2; ++bj)
#pragma unroll
                        for (int n = 0; n < 2; ++n) *(f32x4*)(pp + bj * HALF + n * 16) = gv[bj][n] * acc[ai][bj][m][n]; }
        } else {
#pragma unroll
            for (int ai = 0; ai < 2; ++ai)
#pragma unroll
                for (int mp = 0; mp < 2; ++mp) { f32x4 xv[2][2][2];
#pragma unroll
                    for (int mm = 0; mm < 2; ++mm) { const int row = row0 + ai * HALF + (2 * mp + mm) * 16;
                        const float* xi = (lat ? xin_l + (size_t)row * 1024 : xc + (size_t)(row - XML) * 1024) + col0;
#pragma unroll
                        for (int bj = 0; bj < 2; ++bj)
#pragma unroll
                            for (int n = 0; n < 2; ++n) xv[mm][bj][n] = *(const f32x4*)(xi + bj * HALF + n * 16); }
#pragma unroll
                    for (int mm = 0; mm < 2; ++mm) { const int row = row0 + ai * HALF + (2 * mp + mm) * 16;
                        float* xo = (lat ? xo_l + (size_t)row * 1024 : xc + (size_t)(row - XML) * 1024) + col0;
#pragma unroll
                        for (int bj = 0; bj < 2; ++bj)
#pragma unroll
                            for (int n = 0; n < 2; ++n) *(f32x4*)(xo + bj * HALF + n * 16) = xv[mm][bj][n] + gv[bj][n] * acc[ai][bj][2 * mp + mm][n]; } }
        }
    }
};
struct EpiProj {
    static constexpr bool PERM = true, AFTER_DRAIN = false, KEEP_ACC = false;
    bf16_t* pool; bf16_t* qkv; bf16_t* z; bf16_t* aq; bf16_t* kv; bf16_t* gate;
    __device__ __forceinline__ void operator()(const f32x4 (&acc)[2][2][4][2], const Unit& u, int wr, int wc, int fr, int fq) const {
        const int pn = u.pn; bf16_t* base; int ldc, ct;
        if (pn == 0) { base = pool; ldc = 256; ct = 0; } else if (pn < 4) { base = qkv; ldc = 768; ct = pn - 1; } else if (pn == 4) { base = z; ldc = 256; ct = 0; }
        else if (pn < 7) { base = aq; ldc = 512; ct = pn - 5; } else if (pn == 7) { base = kv; ldc = 256; ct = 0; } else { base = gate; ldc = 3072; ct = pn - 8; }
        const int row0 = u.pm * BM + wr * 64 + fr, col0 = ct * 256 + wc * 32 + 8 * fq;
#pragma unroll
        for (int ai = 0; ai < 2; ++ai)
#pragma unroll
            for (int m = 0; m < 4; ++m) { bf16_t* rowp = base + (size_t)(row0 + ai * HALF + m * 16) * ldc + col0;
#pragma unroll
                for (int bj = 0; bj < 2; ++bj) { const f32x4 v0 = acc[ai][bj][m][0], v1 = acc[ai][bj][m][1];
                    u32x4 w; w.x = cvt_pk_bf16(v0[0], v0[1]); w.y = cvt_pk_bf16(v0[2], v0[3]); w.z = cvt_pk_bf16(v1[0], v1[1]); w.w = cvt_pk_bf16(v1[2], v1[3]);
                    *(u32x4*)(rowp + bj * HALF) = w; } }
    }
};
struct EpiGate {
    static constexpr bool PERM = true, AFTER_DRAIN = false, KEEP_ACC = true;
    const bf16_t* gate; bf16_t* mbf;
    __device__ __forceinline__ void operator()(const f32x4 (&)[2][2][4][2], const Unit&, int, int, int, int) const {}
    __device__ __forceinline__ void mid(f32x4 (&acc)[2][2][4][2], const Unit& u, int wr, int wc, int fr, int fq) const {
        const int row0 = u.pm * BM + wr * 64 + fr, col0 = u.pn * BM + wc * 32 + 8 * fq; const int br = u.part;
#pragma unroll
        for (int ai = 0; ai < 2; ++ai)
#pragma unroll
            for (int m = 0; m < 4; ++m) { const size_t row = (size_t)(row0 + ai * HALF + m * 16);
#pragma unroll
                for (int bj = 0; bj < 2; ++bj) { const int c = col0 + bj * HALF; const bf16_t* gp = gate + row * 3072 + c;
                    if (br < 2) { const u32x4 a = *(const u32x4*)(gp + br * 1024), b = *(const u32x4*)(gp + (br + 1) * 1024);
#pragma unroll
                        for (int e = 0; e < 8; ++e) { const unsigned aw = a[e >> 1], bw = b[e >> 1];
                            float za = __uint_as_float((e & 1) ? (aw & 0xffff0000u) : (aw << 16)), zb = __uint_as_float((e & 1) ? (bw & 0xffff0000u) : (bw << 16));
                            za = fminf(fmaxf(za, -30.f), 30.f); zb = fminf(fmaxf(zb, -30.f), 30.f);
                            acc[ai][bj][m][e >> 2][e & 3] *= (1.f + __expf(-zb)) * __builtin_amdgcn_rcpf(1.f + __expf(-za)); } }
                    else { const u32x4 a = *(const u32x4*)(gp + 2048); float o[8];
#pragma unroll
                        for (int e = 0; e < 8; ++e) { const unsigned aw = a[e >> 1]; float za = __uint_as_float((e & 1) ? (aw & 0xffff0000u) : (aw << 16)); za = fminf(fmaxf(za, -30.f), 30.f);
                            o[e] = acc[ai][bj][m][e >> 2][e & 3] * __builtin_amdgcn_rcpf(1.f + __expf(-za)); }
                        u32x4 w; w.x = cvt_pk_bf16(o[0], o[1]); w.y = cvt_pk_bf16(o[2], o[3]); w.z = cvt_pk_bf16(o[4], o[5]); w.w = cvt_pk_bf16(o[6], o[7]);
                        *(u32x4*)(mbf + row * 1024 + c) = w; } } }
    }
};
template <class Epi, class Sched, bool ALIGN_EPI = false, bool SP2 = false>
__device__ __forceinline__ void gemm_phase(PG8_LAS unsigned char* lds, const Gemm g, const Sched& S, const Epi& E) {
    const int tid = ltid(), wid = __builtin_amdgcn_readfirstlane(tid >> 6), lane = tid & 63, wr = wid >> 2, wc = wid & 3, fr = lane & 15, fq = lane >> 4;
    const int K = g.K, nt = K / BK;
    unsigned voffA[2], voffB[2];
#pragma unroll
    for (int i = 0; i < 2; ++i) { int R, C; stage_rc(tid * 16 + i * 8192, R, C); const int Rb = Epi::PERM ? ((R & ~31) + perm32(R & 31)) : R;
        voffA[i] = (unsigned)(R * K + C) * 2u; voffB[i] = (unsigned)(Rb * K + C) * 2u; }
    const size_t kstep = (size_t)(BK * 2);
    const size_t hstep = (size_t)HALF * K * 2;
    const size_t tstep = 2 * hstep;
    const unsigned ldsw = (unsigned)wid * 1024u;
    const int aoff = lds_byte(wr * 64 + fr, fq * 8), boff = lds_byte(wc * 32 + fr, fq * 8);
#define PG8_SA(b, h) (((b) * 2 + (h)) * HTB)
#define PG8_SB(b, h) ((4 + (b) * 2 + (h)) * HTB)
#define PG8_STAGE(bufoff, gbase, voff) do { _Pragma("unroll") for (int _i = 0; _i < 2; ++_i) \
        __builtin_amdgcn_global_load_lds((const unsigned*)((const char*)(gbase) + (voff)[_i]), (PG8_LAS unsigned*)(lds + (bufoff) + ldsw + _i * 8192), 16, 0, 0); } while (0)
#define PG8_LDA(dst, b, h) do { _Pragma("unroll") for (int m = 0; m < 4; ++m) _Pragma("unroll") for (int k = 0; k < 2; ++k) dst[m][k] = *(const PG8_LAS bf16x8*)(lds + PG8_SA(b, h) + aoff + m * 2048 + k * 1024); } while (0)
#define PG8_LDB(dst, b, h) do { _Pragma("unroll") for (int n = 0; n < 2; ++n) _Pragma("unroll") for (int k = 0; k < 2; ++k) dst[n][k] = *(const PG8_LAS bf16x8*)(lds + PG8_SB(b, h) + boff + n * 2048 + k * 1024); } while (0)
#define PG8_MMA(ai, bj, At, Bt) do { __builtin_amdgcn_s_setprio(1); _Pragma("unroll") for (int m = 0; m < 4; ++m) _Pragma("unroll") for (int n = 0; n < 2; ++n) _Pragma("unroll") for (int k = 0; k < 2; ++k) \
        acc[ai][bj][m][n] = __builtin_amdgcn_mfma_f32_16x16x32_bf16(Bt[n][k], At[m][k], acc[ai][bj][m][n], 0, 0, 0); __builtin_amdgcn_s_setprio(0); } while (0)
#define PG8_WAIT_V(n) asm volatile("s_waitcnt vmcnt(" #n ")" ::: "memory")
#define PG8_WAIT_L(n) asm volatile("s_waitcnt lgkmcnt(" #n ")" ::: "memory")
#define PG8_BAR __builtin_amdgcn_s_barrier()
#define PG8_SCHED __builtin_amdgcn_sched_barrier(0)
    Unit cur, nxt; int ui = 0;
    if (!S.next(0, cur)) return;
    f32x4 acc[2][2][4][2];
#pragma unroll
    for (int a = 0; a < 2; ++a)
#pragma unroll
        for (int b = 0; b < 2; ++b)
#pragma unroll
            for (int m = 0; m < 4; ++m)
#pragma unroll
                for (int n = 0; n < 2; ++n) acc[a][b][m][n] = (f32x4){0.f, 0.f, 0.f, 0.f};
    bf16x8 At[4][2], B0[2][2], B1[2][2];
    const char* cA = (const char*)g.A + (size_t)cur.pm * tstep + (size_t)cur.k0 * kstep; const char* cB = (const char*)g.Bt + (size_t)cur.pn * tstep + (size_t)cur.k0 * kstep;
    S.a_ready(cur);
    if constexpr (SP2) {
        PG8_STAGE(PG8_SB(0, 0), cB, voffB); PG8_STAGE(PG8_SB(0, 1), cB + hstep, voffB); PG8_STAGE(PG8_SA(0, 0), cA, voffA); PG8_STAGE(PG8_SA(0, 1), cA + hstep, voffA);
        if (wr == 1) PG8_BAR;
        PG8_WAIT_V(2); PG8_BAR;
        PG8_STAGE(PG8_SB(1, 0), cB + kstep, voffB); PG8_STAGE(PG8_SA(1, 0), cA + kstep, voffA); PG8_STAGE(PG8_SB(1, 1), cB + hstep + kstep, voffB);
        PG8_WAIT_V(6); PG8_BAR;
    } else {
        PG8_STAGE(PG8_SB(0, 0), cB, voffB); PG8_STAGE(PG8_SA(0, 0), cA, voffA); PG8_STAGE(PG8_SB(0, 1), cB + hstep, voffB); PG8_STAGE(PG8_SA(0, 1), cA + hstep, voffA);
        if (wr == 1) PG8_BAR;
        PG8_WAIT_V(4); PG8_BAR;
        PG8_STAGE(PG8_SB(1, 0), cB + kstep, voffB); PG8_STAGE(PG8_SA(1, 0), cA + kstep, voffA); PG8_STAGE(PG8_SB(1, 1), cB + hstep + kstep, voffB);
        PG8_WAIT_V(6); PG8_BAR;
    }
    for (;;) {
        const bool has_next = S.next(ui + 1, nxt);
        const char* nA = has_next ? (const char*)g.A + (size_t)nxt.pm * tstep + (size_t)nxt.k0 * kstep : cA; const char* nB = has_next ? (const char*)g.Bt + (size_t)nxt.pn * tstep + (size_t)nxt.k0 * kstep : cB;
        const int unt = cur.nt ? cur.nt : nt;
        for (int t = 0; t < unt; t += 2) {
            const bool last = (t == unt - 2);
            const char* a1 = cA + (size_t)(t + 1) * kstep;
            const char* a2 = last ? nA : cA + (size_t)(t + 2) * kstep; const char* b2 = last ? nB : cB + (size_t)(t + 2) * kstep;
            const char* a3 = a2 + kstep; const char* b3 = b2 + kstep;
            if (last && has_next) S.a_ready(nxt);
            if constexpr (SP2) {
            PG8_LDB(B0, 0, 0); PG8_LDB(B1, 0, 1); PG8_SCHED; PG8_LDA(At, 0, 0); PG8_STAGE(PG8_SA(1, 1), a1 + hstep, voffA);
            PG8_WAIT_V(8); PG8_WAIT_L(0); PG8_BAR; PG8_MMA(0, 0, At, B0); PG8_MMA(0, 1, At, B1); PG8_BAR; PG8_SCHED;
            PG8_LDA(At, 0, 1); PG8_STAGE(PG8_SB(0, 0), b2, voffB); PG8_STAGE(PG8_SB(0, 1), b2 + hstep, voffB); PG8_STAGE(PG8_SA(0, 0), a2, voffA);
            PG8_WAIT_V(8); PG8_WAIT_L(0); PG8_BAR; PG8_MMA(1, 0, At, B0); PG8_MMA(1, 1, At, B1); PG8_BAR; PG8_SCHED;
            PG8_LDB(B0, 1, 0); PG8_LDB(B1, 1, 1); PG8_SCHED; PG8_LDA(At, 1, 0); PG8_STAGE(PG8_SA(0, 1), a2 + hstep, voffA);
            PG8_WAIT_V(8); PG8_WAIT_L(0); PG8_BAR; PG8_MMA(0, 0, At, B0); PG8_MMA(0, 1, At, B1); PG8_BAR; PG8_SCHED;
            PG8_LDA(At, 1, 1); PG8_STAGE(PG8_SB(1, 0), b3, voffB); PG8_STAGE(PG8_SB(1, 1), b3 + hstep, voffB); PG8_STAGE(PG8_SA(1, 0), a3, voffA);
            PG8_WAIT_V(8); PG8_WAIT_L(0); PG8_BAR; PG8_MMA(1, 0, At, B0); PG8_MMA(1, 1, At, B1); PG8_BAR; PG8_SCHED;
            } else {
            PG8_LDB(B0, 0, 0); PG8_SCHED; PG8_LDA(At, 0, 0); PG8_STAGE(PG8_SA(1, 1), a1 + hstep, voffA);
            PG8_WAIT_L(8); PG8_BAR; PG8_WAIT_L(0); PG8_MMA(0, 0, At, B0); PG8_BAR; PG8_SCHED;
            PG8_LDB(B1, 0, 1); PG8_STAGE(PG8_SB(0, 0), b2, voffB);
            PG8_BAR; PG8_WAIT_L(0); PG8_MMA(0, 1, At, B1); PG8_BAR;
            PG8_LDA(At, 0, 1); PG8_STAGE(PG8_SA(0, 0), a2, voffA);
            PG8_BAR; PG8_WAIT_L(0); PG8_MMA(1, 0, At, B0); PG8_BAR; PG8_SCHED;
            PG8_STAGE(PG8_SB(0, 1), b2 + hstep, voffB);
            PG8_WAIT_V(6); PG8_BAR; PG8_MMA(1, 1, At, B1); PG8_BAR;
            PG8_LDB(B0, 1, 0); PG8_SCHED; PG8_LDA(At, 1, 0); PG8_STAGE(PG8_SA(0, 1), a2 + hstep, voffA);
            PG8_WAIT_L(8); PG8_BAR; PG8_WAIT_L(0); PG8_MMA(0, 0, At, B0); PG8_BAR; PG8_SCHED;
            PG8_LDB(B1, 1, 1); PG8_STAGE(PG8_SB(1, 0), b3, voffB);
            PG8_BAR; PG8_WAIT_L(0); PG8_MMA(0, 1, At, B1); PG8_BAR;
            PG8_LDA(At, 1, 1); PG8_STAGE(PG8_SA(1, 0), a3, voffA);
            PG8_BAR; PG8_WAIT_L(0); PG8_MMA(1, 0, At, B0); PG8_BAR; PG8_SCHED;
            PG8_STAGE(PG8_SB(1, 1), b3 + hstep, voffB);
            PG8_WAIT_V(6); PG8_BAR; PG8_MMA(1, 1, At, B1); PG8_BAR;
            }
        }
        if constexpr (ALIGN_EPI) { if (wr == 0) PG8_BAR; }
        if constexpr (!Epi::AFTER_DRAIN) { if constexpr (Epi::KEEP_ACC) E.mid(acc, cur, wr, wc, fr, fq); else E(acc, cur, wr, wc, fr, fq); S.done(cur); }
        if (!has_next) break;
        if (!Epi::KEEP_ACC || cur.part >= 2) {
#pragma unroll
        for (int a = 0; a < 2; ++a)
#pragma unroll
            for (int b = 0; b < 2; ++b)
#pragma unroll
                for (int m = 0; m < 4; ++m)
#pragma unroll
                    for (int n = 0; n < 2; ++n) acc[a][b][m][n] = (f32x4){0.f, 0.f, 0.f, 0.f}; }
        cur = nxt; cA = nA; cB = nB; ++ui;
        if constexpr (ALIGN_EPI) { if (wr == 1) PG8_BAR; }
    }
    PG8_WAIT_V(0);
    if constexpr (!ALIGN_EPI) { if (wr == 0) PG8_BAR; }
    PG8_BAR;
    if constexpr (Epi::AFTER_DRAIN) { E.fused(acc, cur, wr, wc, fr, fq, lds, wid, lane); S.done(cur); }
#undef PG8_SA
#undef PG8_SB
#undef PG8_STAGE
#undef PG8_LDA
#undef PG8_LDB
#undef PG8_MMA
#undef PG8_WAIT_V
#undef PG8_WAIT_L
#undef PG8_BAR
#undef PG8_SCHED
}
}
#include <hip/hip_bf16.h>
#include <cmath>
namespace attn_body {
using bf16=__hip_bfloat16;
using bf16x8=__attribute__((ext_vector_type(8)))short;
using s16x4=__attribute__((ext_vector_type(4)))short;
using f32x16=__attribute__((ext_vector_type(16)))float;
using u32x4=__attribute__((ext_vector_type(4)))unsigned;
constexpr int D=64,QP=1024,KP=128;
constexpr int NW=8,QBLK=32,QB=QBLK*NW,KVBLK=64;
__device__ __forceinline__ int crow(int r,int hi){return (r&3)+8*(r>>2)+4*hi;}
#define SBAR() __builtin_amdgcn_sched_barrier(0)
__device__ __forceinline__ void cmask(f32x16&p0,f32x16&p1,int jb,int qrel,int hi){
  const float NEG=-INFINITY; int kb=64*jb+4*hi;
  #pragma unroll
  for(int r=0;r<16;++r){int kv=kb+(r&3)+8*(r>>2); if(kv>qrel)p0[r]=NEG; if(kv+32>qrel)p1[r]=NEG;}
}

constexpr int NSLOT=3, SLOTB=8192;
constexpr int LDS_K=0, LDS_V=NSLOT*SLOTB, LDS_WS=2*NSLOT*SLOTB, LDS_OST=LDS_WS+NW*64*4, LDS_BYTES=LDS_OST+NW*4096;
constexpr float C2=0.125f*1.4426950408889634f;
__device__ __forceinline__ void glds16(const void*gsrc,unsigned lds_dst){unsigned keep;
  asm volatile("s_mov_b32 %0, m0\n\ts_mov_b32 m0, %2\n\ts_nop 0\n\tglobal_load_lds_dwordx4 %1, off\n\ts_mov_b32 m0, %0":"=&s"(keep):"v"(gsrc),"s"(lds_dst):"memory");}
__device__ __forceinline__ float max3f(float a,float b,float c){float r;asm("v_max3_f32 %0, %1, %2, %3":"=v"(r):"v"(a),"v"(b),"v"(c));return r;}
__device__ __forceinline__ float max2f(float a,float b){float r;asm("v_max_f32_e32 %0, %1, %2":"=v"(r):"v"(a),"v"(b));return r;}
__device__ __forceinline__ float fadd_s(float a,float b){float r;asm("v_add_f32_e32 %0, %1, %2":"=v"(r):"v"(a),"v"(b));return r;}
__device__ __forceinline__ float fsub_s(float a,float b){float r;asm("v_sub_f32_e32 %0, %1, %2":"=v"(r):"v"(a),"v"(b));return r;}
typedef float f32x2_t __attribute__((ext_vector_type(2))); typedef __bf16 bf16x2_t __attribute__((ext_vector_type(2)));
__device__ __forceinline__ unsigned cvtpk_s(float lo,float hi){f32x2_t v={lo,hi};bf16x2_t b=__builtin_convertvector(v,bf16x2_t);return __builtin_bit_cast(unsigned,b);}
#define WAIT_BAR(N) asm volatile("s_waitcnt vmcnt(" #N ") lgkmcnt(0)\n\ts_barrier":::"memory")

__device__ __forceinline__ void qkt(f32x16&p0,f32x16&p1,const char*Kslot,const bf16x8*qr,const f32x16&negm,int r32,int hi){
  const char*kb=Kslot+hi*1024+r32*16;
  #pragma unroll
  for(int d0=0;d0<4;++d0){
    const bf16x8 b0=*reinterpret_cast<const bf16x8*>(kb+d0*2048);
    const bf16x8 b1=*reinterpret_cast<const bf16x8*>(kb+d0*2048+512);
    if(d0==0){p0=__builtin_amdgcn_mfma_f32_32x32x16_bf16(b0,qr[0],negm,0,0,0);p1=__builtin_amdgcn_mfma_f32_32x32x16_bf16(b1,qr[0],negm,0,0,0);}
    else{p0=__builtin_amdgcn_mfma_f32_32x32x16_bf16(b0,qr[d0],p0,0,0,0);p1=__builtin_amdgcn_mfma_f32_32x32x16_bf16(b1,qr[d0],p1,0,0,0);}}
}
typedef __attribute__((address_space(3))) const char* lds_cptr;
typedef short v4i16_t __attribute__((ext_vector_type(4)));
__device__ __forceinline__ void kload8(bf16x8*kf,lds_cptr kp){
  kf[0]=*(const __attribute__((address_space(3))) bf16x8*)(kp);      kf[1]=*(const __attribute__((address_space(3))) bf16x8*)(kp+512);
  kf[2]=*(const __attribute__((address_space(3))) bf16x8*)(kp+2048); kf[3]=*(const __attribute__((address_space(3))) bf16x8*)(kp+2560);
  kf[4]=*(const __attribute__((address_space(3))) bf16x8*)(kp+4096); kf[5]=*(const __attribute__((address_space(3))) bf16x8*)(kp+4608);
  kf[6]=*(const __attribute__((address_space(3))) bf16x8*)(kp+6144); kf[7]=*(const __attribute__((address_space(3))) bf16x8*)(kp+6656);
}
__device__ __forceinline__ void kload2(bf16x8*kf,lds_cptr kp,int j){ kf[2*j]=*(const __attribute__((address_space(3))) bf16x8*)(kp+j*2048); kf[2*j+1]=*(const __attribute__((address_space(3))) bf16x8*)(kp+j*2048+512); }
__device__ __forceinline__ s16x4 vtr(lds_cptr p){ return __builtin_bit_cast(s16x4,__builtin_amdgcn_ds_read_tr16_b64_v4i16((__attribute__((address_space(3))) v4i16_t*)p)); }
__device__ __forceinline__ float rowmax(const f32x16&p0,const f32x16&p1){
  float a=max3f(p0[0],p0[1],p1[0]),b=max3f(p0[2],p0[3],p1[1]);a=max3f(a,p1[2],p1[3]);
  #pragma unroll
  for(int r=4;r<16;r+=4){a=max3f(a,p0[r],p0[r+1]);b=max3f(b,p0[r+2],p0[r+3]);a=max3f(a,p1[r],p1[r+1]);b=max3f(b,p1[r+2],p1[r+3]);}
  const float m=max2f(a,b);
  auto rr=__builtin_amdgcn_permlane32_swap(__float_as_uint(m),__float_as_uint(m),false,false);
  return max2f(__uint_as_float(rr[0]),__uint_as_float(rr[1]));
}
__device__ __forceinline__ void pv(f32x16*o,int vb,bf16x8 pa0,bf16x8 pa1,bf16x8 pa2,bf16x8 pa3){
  #pragma unroll
  for(int d0=0;d0<2;++d0){s16x4 lo[4],hi[4];
    #pragma unroll
    for(int ks=0;ks<4;++ks){
      asm volatile("ds_read_b64_tr_b16 %0,%1 offset:%c2":"=&v"(lo[ks]):"v"(vb),"i"(d0*4096+ks*1024):"memory");
      asm volatile("ds_read_b64_tr_b16 %0,%1 offset:%c2":"=&v"(hi[ks]):"v"(vb),"i"(d0*4096+ks*1024+512):"memory");}
    asm volatile("s_waitcnt lgkmcnt(0)":::"memory");SBAR();
    #define PK(k) (bf16x8){lo[k][0],lo[k][1],lo[k][2],lo[k][3],hi[k][0],hi[k][1],hi[k][2],hi[k][3]}
    o[d0]=__builtin_amdgcn_mfma_f32_32x32x16_bf16(pa0,PK(0),o[d0],0,0,0);
    o[d0]=__builtin_amdgcn_mfma_f32_32x32x16_bf16(pa1,PK(1),o[d0],0,0,0);
    o[d0]=__builtin_amdgcn_mfma_f32_32x32x16_bf16(pa2,PK(2),o[d0],0,0,0);
    o[d0]=__builtin_amdgcn_mfma_f32_32x32x16_bf16(pa3,PK(3),o[d0],0,0,0);
    #undef PK
  }
}

#ifndef ATTN_STORE16
#define ATTN_STORE16(p,v) (*(u32x4*)(p)=(v))
#endif
template<int THRL> __device__ __forceinline__ void attn_unit(const bf16*Qu,const bf16*__restrict__ Kh,const bf16*__restrict__ Vh,bf16*Ou,const int NT,char*shm){
  const int tid=ltid(),lane=tid&63,r32=lane&31,hi=lane>>5; const int wid=__builtin_amdgcn_readfirstlane(tid>>6);
  const bf16*Qw=Qu+(long)(wid*QBLK)*QP;
  const unsigned lds0=(unsigned)(uintptr_t)shm;
  float*wsf=(float*)(shm+LDS_WS)+wid*64;
  const bf16*ksrc=Kh+(long)lane*KP+wid*8;
  const bf16*vsrc=Vh+(long)(16*(wid&3)+(lane>>2))*KP+(wid>>2)*32+(lane&3)*8;
  const unsigned kdst=lds0+LDS_K+wid*1024, vdst=lds0+LDS_V+wid*1024;
  #define DMA_K(t,slot) glds16(ksrc+(long)(t)*KVBLK*KP,(unsigned)__builtin_amdgcn_readfirstlane(kdst+(slot)))
  #define DMA_V(t,slot) glds16(vsrc+(long)(t)*KVBLK*KP,(unsigned)__builtin_amdgcn_readfirstlane(vdst+(slot)))
  const int vb0=(int)(lds0+LDS_V)+((lane>>4)&1)*32+(lane&3)*8+(4*hi+((lane&15)>>2))*64;
  const char*Kbase=shm+LDS_K; bf16x8 kf[8];
  const lds_cptr shm3=(lds_cptr)shm; const lds_cptr kp0=shm3+LDS_K+hi*1024+r32*16; const lds_cptr vp0=shm3+LDS_V+((lane>>4)&1)*32+(lane&3)*8+(4*hi+((lane&15)>>2))*64;
  DMA_K(0,0);DMA_V(0,0);DMA_K(1,SLOTB);
  bf16x8 qr[4];
  #pragma unroll
  for(int d0=0;d0<4;++d0)qr[d0]=*reinterpret_cast<const bf16x8*>(&Qw[(long)r32*QP+d0*16+hi*8]);
  float mhat=0.f,l_reg=0.f;f32x16 o[2];o[0]=f32x16{};o[1]=f32x16{};f32x16 negm=f32x16{};asm volatile("":"+v"(negm));
  #define CMASK(P0,P1,t) do{}while(0)
  bool resc=false;
  #define START(P0,P1) do{ const float rm=rowmax(P0,P1); resc=false; \
    { const float dl=rm; mhat=fadd_s(mhat,dl); \
      _Pragma("unroll") for(int r=0;r<16;++r){P0[r]=fsub_s(P0[r],dl);P1[r]=fsub_s(P1[r],dl);} \
      _Pragma("unroll") for(int r=0;r<16;++r)negm[r]=-mhat; asm volatile("":"+v"(negm)); } \
    _Pragma("unroll") for(int r=0;r<16;++r)P0[r]=__builtin_amdgcn_exp2f(P0[r]); }while(0)
  #define RESC() do{ if(resc){ asm volatile("s_waitcnt lgkmcnt(0)":::"memory"); \
      _Pragma("unroll") for(int d_=0;d_<2;++d_) _Pragma("unroll") for(int r=0;r<16;++r)o[d_][r]*=wsf[crow(r,hi)]; } }while(0)
  f32x16 pA0,pA1,pB0,pB1;
  int sl_prev=0,sl_cur=0,sl_next=SLOTB;
  #define ROT() do{sl_prev=sl_cur;sl_cur=sl_next;sl_next=(sl_next==(NSLOT-1)*SLOTB)?0:sl_next+SLOTB;}while(0)
  DMA_K(2,2*SLOTB);
  WAIT_BAR(3);
  qkt(pA0,pA1,Kbase,qr,negm,r32,hi);asm volatile("s_nop 15\n\ts_nop 7":"+v"(pA0),"+v"(pA1));CMASK(pA0,pA1,0);
  START(pA0,pA1);
  _Pragma("unroll") for(int r=0;r<16;++r)pA1[r]=__builtin_amdgcn_exp2f(pA1[r]);
  WAIT_BAR(0);
  DMA_K(3,0);DMA_V(1,SLOTB);
  ROT();
  kload8(kf,kp0+sl_cur);
  WAIT_BAR(2);
  s16x4 vlo[8],vhi[8]; u32x4 pw0,pw1,pw2,pw3;
  #define PKW(P,B) cvtpk_s(P[B],P[B+1])
  #define PAF(k) __builtin_bit_cast(bf16x8,pw##k)
  #define VFR(i) (bf16x8){vlo[i][0],vlo[i][1],vlo[i][2],vlo[i][3],vhi[i][0],vhi[i][1],vhi[i][2],vhi[i][3]}
  #define PIN(x) asm volatile("":"+v"(x))
  #define MX3(a,b,c) __builtin_fmaxf(__builtin_fmaxf((a),(b)),(c))
  #define GAPA(MF,A0,A1,A2,A3,W0,W1,PW) do{ MF; sacc+=A0; sacc+=A1; sacc+=A2; sacc+=A3; PIN(sacc); W0; W1; PIN(PW); SBAR(); }while(0)
  #define EX(v) __builtin_amdgcn_exp2f(v)
  #define GAPB(MF,X,B) do{ MF; X[B]=EX(X[B]); X[B+1]=EX(X[B+1]); X[B+2]=EX(X[B+2]); X[B+3]=EX(X[B+3]); PIN(X); SBAR(); }while(0)
  #define VRD(i) do{ vlo[i]=vtr(vp_+(((i)>>2)*4096+((i)&3)*1024)); vhi[i]=vtr(vp_+(((i)>>2)*4096+((i)&3)*1024+512)); }while(0)
  #define KRD(G,j) do{ if(G){ kload2(kf,kp0+sl_next,j); SBAR(); } }while(0)
  #define STEP(C0,C1,P0,P1,t,GK,GV,GL) do{ SBAR(); \
    const lds_cptr vp_=vp0+sl_prev; \
    VRD(0); SBAR(); float sacc=(P0[0]+P0[1]); \
    GAPA(C0=__builtin_amdgcn_mfma_f32_32x32x16_bf16(kf[0],qr[0],negm,0,0,0), P0[2],P0[3],P0[4],P0[5],     pw0[0]=PKW(P0,0), pw0[1]=PKW(P0,2), pw0); \
    VRD(4); SBAR(); GAPA(C1=__builtin_amdgcn_mfma_f32_32x32x16_bf16(kf[1],qr[0],negm,0,0,0), P0[6],P0[7],P0[8],P0[9],     pw0[2]=PKW(P0,4), pw0[3]=PKW(P0,6), pw0); \
    VRD(1); SBAR(); GAPA(C0=__builtin_amdgcn_mfma_f32_32x32x16_bf16(kf[2],qr[1],C0,0,0,0),   P0[10],P0[11],P0[12],P0[13], pw1[0]=PKW(P0,8), pw1[1]=PKW(P0,10), pw1); \
    VRD(5); SBAR(); GAPA(C1=__builtin_amdgcn_mfma_f32_32x32x16_bf16(kf[3],qr[1],C1,0,0,0),   P0[14],P0[15],P1[0],P1[1],   pw1[2]=PKW(P0,12),pw1[3]=PKW(P0,14), pw1); \
    VRD(2); SBAR(); GAPA(C0=__builtin_amdgcn_mfma_f32_32x32x16_bf16(kf[4],qr[2],C0,0,0,0),   P1[2],P1[3],P1[4],P1[5],     pw2[0]=PKW(P1,0), pw2[1]=PKW(P1,2), pw2); \
    VRD(6); SBAR(); GAPA(C1=__builtin_amdgcn_mfma_f32_32x32x16_bf16(kf[5],qr[2],C1,0,0,0),   P1[6],P1[7],P1[8],P1[9],     pw2[2]=PKW(P1,4), pw2[3]=PKW(P1,6), pw2); \
    VRD(3); SBAR(); GAPA(C0=__builtin_amdgcn_mfma_f32_32x32x16_bf16(kf[6],qr[3],C0,0,0,0),   P1[10],P1[11],P1[12],P1[13], pw3[0]=PKW(P1,8), pw3[1]=PKW(P1,10), pw3); \
    VRD(7); SBAR(); GAPA(C1=__builtin_amdgcn_mfma_f32_32x32x16_bf16(kf[7],qr[3],C1,0,0,0),   P1[14],P1[15],0.f,0.f,       pw3[2]=PKW(P1,12),pw3[3]=PKW(P1,14), pw3); \
    l_reg+=sacc; \
    if(GK){DMA_K((t)+3,sl_cur);} if(GV){DMA_V((t)+1,sl_next);} \
    CMASK(C0,C1,t); \
    { float a=MX3(C0[0],C0[1],C1[0]),b=MX3(C0[2],C0[3],C1[1]); a=MX3(a,C1[2],C1[3]); \
      _Pragma("unroll") for(int r=4;r<16;r+=4){a=MX3(a,C0[r],C0[r+1]);b=MX3(b,C0[r+2],C0[r+3]);a=MX3(a,C1[r],C1[r+1]);b=MX3(b,C1[r+2],C1[r+3]);} \
      float rm=__builtin_fmaxf(a,b); { auto rr=__builtin_amdgcn_permlane32_swap(__float_as_uint(rm),__float_as_uint(rm),false,false); rm=__builtin_fmaxf(__uint_as_float(rr[0]),__uint_as_float(rr[1])); } \
      resc=false; \
      if(__builtin_expect(__any(rm>(float)THRL),0)){ const float dl=__builtin_fmaxf(rm,0.f); mhat+=dl; \
        _Pragma("unroll") for(int r=0;r<16;++r){C0[r]-=dl;C1[r]-=dl;} \
        _Pragma("unroll") for(int r=0;r<16;++r)negm[r]=-mhat; asm volatile("":"+v"(negm)); \
        const float f=__builtin_amdgcn_exp2f(-dl); l_reg*=f; if(hi==0)wsf[r32]=f; resc=true; } } \
    SBAR(); \
    GAPB(o[0]=__builtin_amdgcn_mfma_f32_32x32x16_bf16(PAF(0),VFR(0),o[0],0,0,0), C0,0); \
    GAPB(o[1]=__builtin_amdgcn_mfma_f32_32x32x16_bf16(PAF(0),VFR(4),o[1],0,0,0), C0,4); \
    KRD(GL,0); GAPB(o[0]=__builtin_amdgcn_mfma_f32_32x32x16_bf16(PAF(1),VFR(1),o[0],0,0,0), C0,8); \
    KRD(GL,1); GAPB(o[1]=__builtin_amdgcn_mfma_f32_32x32x16_bf16(PAF(1),VFR(5),o[1],0,0,0), C0,12); \
    KRD(GL,2); GAPB(o[0]=__builtin_amdgcn_mfma_f32_32x32x16_bf16(PAF(2),VFR(2),o[0],0,0,0), C1,0); \
    KRD(GL,3); GAPB(o[1]=__builtin_amdgcn_mfma_f32_32x32x16_bf16(PAF(2),VFR(6),o[1],0,0,0), C1,4); \
    GAPB(o[0]=__builtin_amdgcn_mfma_f32_32x32x16_bf16(PAF(3),VFR(3),o[0],0,0,0), C1,8); \
    GAPB(o[1]=__builtin_amdgcn_mfma_f32_32x32x16_bf16(PAF(3),VFR(7),o[1],0,0,0), C1,12); \
    }while(0)
  int t=1;
  #undef CMASK
  #define CMASK(P0,P1,t) do{}while(0)
  for(;t+5<NT;t+=2){
    STEP(pB0,pB1,pA0,pA1,t,true,true,true);     WAIT_BAR(2); RESC(); ROT();
    STEP(pA0,pA1,pB0,pB1,t+1,true,true,true);   WAIT_BAR(2); RESC(); ROT();
  }
  #undef CMASK
  #define CMASK(P0,P1,t) do{}while(0)
  #define ENDW(tt) do{ if((tt)+3<NT){WAIT_BAR(2);} else if((tt)+2<NT){WAIT_BAR(1);} else {WAIT_BAR(0);} }while(0)
  for(;t+1<NT;t+=2){
    STEP(pB0,pB1,pA0,pA1,t,(t+3<NT),(t+1<NT),(t+1<NT));       ENDW(t);   RESC(); ROT();
    STEP(pA0,pA1,pB0,pB1,t+1,(t+4<NT),(t+2<NT),(t+2<NT));     ENDW(t+1); RESC(); ROT();
  }
  STEP(pB0,pB1,pA0,pA1,NT-1,false,false,false); RESC();
  { float sacc=pB0[0]+pB0[1]; _Pragma("unroll") for(int r=2;r<16;++r)sacc+=pB0[r]; _Pragma("unroll") for(int r=0;r<16;++r)sacc+=pB1[r]; l_reg+=sacc;
    pw0=(u32x4){PKW(pB0,0),PKW(pB0,2),PKW(pB0,4),PKW(pB0,6)};pw1=(u32x4){PKW(pB0,8),PKW(pB0,10),PKW(pB0,12),PKW(pB0,14)};pw2=(u32x4){PKW(pB1,0),PKW(pB1,2),PKW(pB1,4),PKW(pB1,6)};pw3=(u32x4){PKW(pB1,8),PKW(pB1,10),PKW(pB1,12),PKW(pB1,14)};
    SBAR(); pv(o,vb0+sl_cur,PAF(0),PAF(1),PAF(2),PAF(3)); }
  #undef PKW
  #undef PAF
  #undef VFR
  #undef PIN
  #undef MX3
  #undef GAPA
  #undef GAPB
  #undef EX
  #undef VRD
  #undef KRD
  #undef STEP
  #undef ENDW
  {auto rr=__builtin_amdgcn_permlane32_swap(__float_as_uint(l_reg),__float_as_uint(l_reg),false,false);l_reg=__uint_as_float(rr[0])+__uint_as_float(rr[1]);}
  if(hi==0)wsf[32+r32]=l_reg;asm volatile("s_waitcnt lgkmcnt(0)":::"memory");
  float rli[16];
  #pragma unroll
  for(int r=0;r<16;++r)rli[r]=__builtin_amdgcn_rcpf(wsf[32+crow(r,hi)]);
  bf16*Ow=Ou+(long)(wid*QBLK)*QP;
  { bf16*stg=(bf16*)(shm+LDS_OST)+wid*2048;
    #pragma unroll
    for(int r=0;r<16;++r){const int orow=crow(r,hi);
      #pragma unroll
      for(int d0=0;d0<2;++d0)stg[orow*64+d0*32+r32]=__float2bfloat16(o[d0][r]*rli[r]);}
    asm volatile("s_waitcnt lgkmcnt(0)":::"memory");
    #pragma unroll
    for(int i=0;i<4;++i){const int row=i*8+(lane>>3),ch=lane&7; const u32x4 v=*(const u32x4*)(stg+row*64+ch*8); ATTN_STORE16(Ow+(long)row*QP+ch*8,v);} }
  asm volatile("s_waitcnt lgkmcnt(0)\n\ts_barrier":::"memory");
  #undef DMA_K
  #undef DMA_V
  #undef CMASK
  #undef START
  #undef RESC
  #undef ROT
}
constexpr int ATTN_LDS_BYTES=LDS_BYTES;
#undef SBAR
#undef WAIT_BAR
}
typedef unsigned short bf16_t;
typedef short bf16x8 __attribute__((ext_vector_type(8)));
typedef float f32x4 __attribute__((ext_vector_type(4)));
constexpr int DM = 1024, NB = 8, SEQ = 4096, CTXL = 256, DEPTH = 4, DFF = 2816;
constexpr int ML = NB * SEQ, MC = NB * CTXL, MT = ML + MC;
constexpr int INC = 5136, MODW = 9 * DM, NCH = 68, KVR = CTXL + SEQ;
static_assert(ML == pg8::XML, "row split");
constexpr size_t MiB = 1u << 20;
constexpr size_t WS_MOD = 0, WS_CTR = 1536 * 1024, WS_BAR = WS_CTR + 4096, WS_CTL_BYTES = 65536, WS_XC = 2 * MiB, WS_H = 10 * MiB;
constexpr size_t WS_Y = WS_H;
constexpr size_t WS_WB = 78 * MiB;
constexpr size_t WS_W1IN = WS_WB, WS_W1OUT = WS_W1IN + (size_t)5632 * 1024 * 2, WS_WIN = WS_W1OUT + (size_t)1024 * 2816 * 2, WS_WA = WS_WIN + (size_t)5120 * 1024 * 2,
                 WS_WBB = WS_WA + (size_t)1024 * 256 * 2, WS_WC = WS_WBB + (size_t)1024 * 256 * 2, WS_WOUT = WS_WC + (size_t)1024 * 512 * 2, WS_W2IN = WS_WOUT + (size_t)1024 * 1024 * 2,
                 WS_W2OUT = WS_W2IN + (size_t)5632 * 1024 * 2, WS_WB_END = WS_W2OUT + (size_t)1024 * 2816 * 2;
constexpr size_t WS_R = 125 * MiB;
static_assert(WS_WB_END <= WS_R, "ws map");
constexpr size_t WS_ACT = WS_R, WS_PGATE = WS_R, WS_PZ = WS_R + 204 * MiB, WS_PAQ = WS_R + 221 * MiB, WS_PKV = WS_R + 255 * MiB, WS_PQKV = WS_R + 272 * MiB,
                 WS_OF = WS_PQKV, WS_OB = WS_PAQ  , WS_MBF = WS_PQKV, WS_PPOOL = WS_R + 323 * MiB, WS_DNU = WS_R + 340 * MiB, WS_M32 = WS_DNU, WS_DNW = WS_R + 374 * MiB,
                 WS_DNQK = WS_R + 408 * MiB, WS_DNKT = WS_R + 442 * MiB, WS_DNQN = WS_R + 476 * MiB, WS_DNG = WS_R + 493 * MiB, WS_BA = WS_R + 495 * MiB, WS_KATT = WS_R + 498 * MiB, WS_VATT = WS_KATT + (size_t)NB * KVR * 128 * 2, WS_END = WS_R + 516 * MiB;
constexpr int LDS_BYTES = 147456;

struct Args { const float* in[25]; float* out; unsigned char* ws; };
enum { I_X = 0, I_C, I_CTX, I_CCTX, I_WADA, I_BADA, I_NF1, I_F1IN, I_F1OUT, I_NMIX, I_WIN, I_POOLW, I_POOLS, I_CONV, I_ALOG, I_DTB, I_DNN, I_QN, I_KN, I_WBR, I_WOUT, I_NF2, I_F2IN, I_F2OUT, I_NFIN };

__device__ __forceinline__ float bf2f(unsigned v) { return __uint_as_float(v << 16); }
typedef float f32x2_c __attribute__((ext_vector_type(2))); typedef __bf16 bf16x2_c __attribute__((ext_vector_type(2)));
__device__ __forceinline__ unsigned pk2(float lo, float hi) { f32x2_c v = {lo, hi}; bf16x2_c b = __builtin_convertvector(v, bf16x2_c); return __builtin_bit_cast(unsigned, b); }
__device__ __forceinline__ float wave_sum(float v) {
#pragma unroll
    for (int o = 32; o >= 1; o >>= 1) v += __shfl_xor(v, o);
    return v;
}
__device__ __forceinline__ void unpack8(const uint4 r, float* v) {
    v[0] = __uint_as_float(r.x << 16); v[1] = __uint_as_float(r.x & 0xffff0000u); v[2] = __uint_as_float(r.y << 16); v[3] = __uint_as_float(r.y & 0xffff0000u);
    v[4] = __uint_as_float(r.z << 16); v[5] = __uint_as_float(r.z & 0xffff0000u); v[6] = __uint_as_float(r.w << 16); v[7] = __uint_as_float(r.w & 0xffff0000u);
}
__device__ __forceinline__ uint4 pack8(const float* v) { uint4 r; r.x = pk2(v[0], v[1]); r.y = pk2(v[2], v[3]); r.z = pk2(v[4], v[5]); r.w = pk2(v[6], v[7]); return r; }
__device__ __forceinline__ int permk(int k) { return (k & 32) | (((k >> 2) & 3) << 3) | (((k >> 4) & 1) << 2) | (k & 3); }
__device__ __forceinline__ int unpermk(int p) { return (p & 32) | (((p >> 2) & 1) << 4) | (((p >> 3) & 3) << 2) | (p & 3); }

__device__ __forceinline__ void mods_phase(const Args& a, float* ldsf, float* MOD) {
    const int tid = ltid();
    float* s = ldsf; float* red = ldsf + 9 * 1024;
    for (int i = tid; i < 9 * 1024; i += 512) { const int r = i >> 10, k = i & 1023; const float v = r < 8 ? a.in[I_C][r * 1024 + k] : a.in[I_CCTX][k]; s[i] = v / (1.f + expf(-v)); }
    __syncthreads();
    for (int task = lbid(); task < DEPTH * 144; task += lgdim()) {
        const int l = task / 144, cb = task % 144, cl = tid & 63, kg = tid >> 6;
        const float* w = a.in[I_WADA] + ((size_t)l * 1024 + kg * 128) * MODW + cb * 64 + cl;
        float acc[9];
#pragma unroll
        for (int r = 0; r < 9; ++r) acc[r] = 0.f;
#pragma unroll 16
        for (int k = 0; k < 128; ++k) { const float wv = w[(size_t)k * MODW];
#pragma unroll
            for (int r = 0; r < 9; ++r) acc[r] += s[r * 1024 + kg * 128 + k] * wv; }
#pragma unroll
        for (int r = 0; r < 9; ++r) red[(kg * 9 + r) * 64 + cl] = acc[r];
        __syncthreads();
        for (int i = tid; i < 9 * 64; i += 512) { const int r = i >> 6, cc = i & 63; float v = 0.f;
#pragma unroll
            for (int g8 = 0; g8 < 8; ++g8) v += red[(g8 * 9 + r) * 64 + cc];
            MOD[((size_t)l * 9 + r) * MODW + cb * 64 + cc] = v + a.in[I_BADA][(size_t)l * MODW + cb * 64 + cc]; }
        __syncthreads();
    }
}

__device__ __forceinline__ int tmap(int map, int n) { return map == 0 ? n : (map == 1 ? ((n >> 8) * 128 + (n & 127) + ((n >> 7) & 1) * DFF) : (n < 1280 ? n : n + 16)); }
__device__ __forceinline__ void tconv_tile(const float* src, int pitch, int K, int map, bf16_t* dst, int t, float* tile, int tid) {
    const int ntk = K / 64, n0 = (t / ntk) * 64, k0 = (t % ntk) * 64, sc0 = tmap(map, n0);
#pragma unroll
    for (int i = 0; i < 2; ++i) { const int kk = (tid >> 4) + 32 * i, c4 = (tid & 15) * 4;
        const float4 v = *(const float4*)(src + (size_t)(k0 + kk) * pitch + sc0 + c4);
        float* p = tile + kk * 65 + c4; p[0] = v.x; p[1] = v.y; p[2] = v.z; p[3] = v.w; }
    __syncthreads();
    { const int nn = tid >> 3, kq = tid & 7; float v[8];
#pragma unroll
      for (int j = 0; j < 8; ++j) v[j] = tile[(kq * 8 + j) * 65 + nn];
      *(uint4*)(dst + (size_t)(n0 + nn) * K + k0 + kq * 8) = pack8(v); }
    __syncthreads();
}
__device__ __forceinline__ void tconv_mat(const float* src, int pitch, int K, int Nout, int map, bf16_t* dst, int& goff, float* tile) {
    const int tid = ltid(), G = lgdim(), ntk = K / 64, ntiles = (Nout / 64) * ntk;
    int t = (lbid() - goff % G + G) % G;
    for (; t < ntiles; t += G) {
        const int n0 = (t / ntk) * 64, k0 = (t % ntk) * 64, sc0 = tmap(map, n0);
#pragma unroll
        for (int i = 0; i < 2; ++i) { const int kk = (tid >> 4) + 32 * i, c4 = (tid & 15) * 4;
            const float4 v = *(const float4*)(src + (size_t)(k0 + kk) * pitch + sc0 + c4);
            float* p = tile + kk * 65 + c4; p[0] = v.x; p[1] = v.y; p[2] = v.z; p[3] = v.w; }
        __syncthreads();
        { const int nn = tid >> 3, kq = tid & 7; float v[8];
#pragma unroll
          for (int j = 0; j < 8; ++j) v[j] = tile[(kq * 8 + j) * 65 + nn];
          *(uint4*)(dst + (size_t)(n0 + nn) * K + k0 + kq * 8) = pack8(v); }
        __syncthreads();
    }
    goff += ntiles;
}
__device__ __forceinline__ void weights_phase(const Args& a, int l, unsigned char* ws, float* ldsf, bool first3) {
    int goff = 0;
    if (first3) {
    tconv_mat(a.in[I_F1IN] + (size_t)l * 1024 * 5632, 5632, 1024, 5632, 1, (bf16_t*)(ws + WS_W1IN), goff, ldsf);
    tconv_mat(a.in[I_F1OUT] + (size_t)l * 2816 * 1024, 1024, 2816, 1024, 0, (bf16_t*)(ws + WS_W1OUT), goff, ldsf);
    tconv_mat(a.in[I_WIN] + (size_t)l * 1024 * INC, INC, 1024, 5120, 2, (bf16_t*)(ws + WS_WIN), goff, ldsf); }
    tconv_mat(a.in[I_WBR] + (size_t)l * 1024 * 1024, 1024, 1024, 1024, 0, (bf16_t*)(ws + WS_WA), goff, ldsf);
    tconv_mat(a.in[I_WOUT] + (size_t)l * 1024 * 1024, 1024, 1024, 1024, 0, (bf16_t*)(ws + WS_WOUT), goff, ldsf);
    tconv_mat(a.in[I_F2IN] + (size_t)l * 1024 * 5632, 5632, 1024, 5632, 1, (bf16_t*)(ws + WS_W2IN), goff, ldsf);
    tconv_mat(a.in[I_F2OUT] + (size_t)l * 2816 * 1024, 1024, 2816, 1024, 0, (bf16_t*)(ws + WS_W2OUT), goff, ldsf);
}

__device__ __forceinline__ void norm_phase(const float* xl, const float* xc, const float* gn, const float* modl, int jshift, bf16_t* H, int nrows, float* xcw, const float* PART, int nparts) {
    const int tid_ = ltid(), lane = tid_ & 63, gw = lbid() * 8 + (tid_ >> 6), nw = lgdim() * 8;
    float4 gq[4], nx[4];
#pragma unroll
    for (int i = 0; i < 4; ++i) { gq[i] = *(const float4*)(gn + i * 256 + lane * 4); nx[i] = make_float4(0.f, 0.f, 0.f, 0.f); }
    if (gw < nrows) { const float* x0 = gw < ML ? xl + (size_t)gw * 1024 : xc + (size_t)(gw - ML) * 1024;
#pragma unroll
        for (int i = 0; i < 4; ++i) nx[i] = *(const float4*)(x0 + i * 256 + lane * 4); }
    for (int row = gw; row < nrows; row += nw) {
        const float* sh = modl + (size_t)(row < ML ? (row >> 12) : 8) * MODW + jshift * 1024; const float* sc = sh + 1024;
        float4 v[4]; float ss = 0.f;
#pragma unroll
        for (int i = 0; i < 4; ++i) v[i] = nx[i];
        { const int nrow = row + nw;
          if (nrow < nrows) { const float* xn = nrow < ML ? xl + (size_t)nrow * 1024 : xc + (size_t)(nrow - ML) * 1024;
#pragma unroll
              for (int i = 0; i < 4; ++i) nx[i] = *(const float4*)(xn + i * 256 + lane * 4); } }
        if (row >= ML && nparts > 0) {
            const float* pp0 = PART + (size_t)(row - ML) * 1024 + lane * 4;
#pragma unroll
            for (int i = 0; i < 4; ++i) { float4 d[8];
#pragma unroll
                for (int p = 0; p < 8; ++p) d[p] = p < nparts ? *(const float4*)(pp0 + (size_t)p * MC * 1024 + i * 256) : make_float4(0.f, 0.f, 0.f, 0.f);
#pragma unroll
                for (int p = 0; p < 8; ++p) { v[i].x += d[p].x; v[i].y += d[p].y; v[i].z += d[p].z; v[i].w += d[p].w; } }
#pragma unroll
            for (int i = 0; i < 4; ++i) *(float4*)(xcw + (size_t)(row - ML) * 1024 + i * 256 + lane * 4) = v[i]; }
#pragma unroll
        for (int i = 0; i < 4; ++i) ss += v[i].x * v[i].x + v[i].y * v[i].y + v[i].z * v[i].z + v[i].w * v[i].w;
        ss = wave_sum(ss); const float rstd = rsqrtf(ss * (1.f / 1024.f) + 1e-6f);
#pragma unroll
        for (int i = 0; i < 4; ++i) { const int c = i * 256 + lane * 4; const float4 g = gq[i], s4 = *(const float4*)(sh + c), c4 = *(const float4*)(sc + c);
            uint2 o; o.x = pk2(v[i].x * rstd * g.x * (1.f + c4.x) + s4.x, v[i].y * rstd * g.y * (1.f + c4.y) + s4.y);
            o.y = pk2(v[i].z * rstd * g.z * (1.f + c4.z) + s4.z, v[i].w * rstd * g.w * (1.f + c4.w) + s4.w);
            *(uint2*)(H + (size_t)row * 1024 + c) = o; }
    }
}
__device__ __forceinline__ void final_norm_phase(float* x, const float* gn) {
    const int tid_ = ltid(), lane = tid_ & 63, gw = lbid() * 8 + (tid_ >> 6), nw = lgdim() * 8;
    for (int row = gw; row < ML; row += nw) {
        float* xr = x + (size_t)row * 1024; float4 v[4]; float ss = 0.f;
#pragma unroll
        for (int i = 0; i < 4; ++i) { v[i] = *(const float4*)(xr + i * 256 + lane * 4); ss += v[i].x * v[i].x + v[i].y * v[i].y + v[i].z * v[i].z + v[i].w * v[i].w; }
        ss = wave_sum(ss); const float rstd = rsqrtf(ss * (1.f / 1024.f) + 1e-6f);
#pragma unroll
        for (int i = 0; i < 4; ++i) { const int c = i * 256 + lane * 4; const float4 g = *(const float4*)(gn + c);
            *(float4*)(xr + c) = make_float4(v[i].x * rstd * g.x, v[i].y * rstd * g.y, v[i].z * rstd * g.z, v[i].w * rstd * g.w); }
    }
}

__device__ __forceinline__ void ba_phase(const float* win_l, const bf16_t* H, float* BA, float* ldsf) {
    const int tid = ltid(), lane = tid & 63, gw = lbid() * 8 + (tid >> 6), nw = lgdim() * 8;
    for (int i = tid; i < 16 * 1024; i += 512) { const int k = i >> 4, j = i & 15; ldsf[j * 1024 + k] = win_l[(size_t)k * INC + 1280 + j]; }
    __syncthreads();
    unsigned hv[8], hn[8];
#pragma unroll
    for (int i = 0; i < 8; ++i) hn[i] = gw < MT ? *(const unsigned*)(H + (size_t)gw * 1024 + i * 128 + lane * 2) : 0u;
    for (int row = gw; row < MT; row += nw) {
#pragma unroll
        for (int i = 0; i < 8; ++i) hv[i] = hn[i];
        const int nrow = row + nw;
        if (nrow < MT) {
#pragma unroll
            for (int i = 0; i < 8; ++i) hn[i] = *(const unsigned*)(H + (size_t)nrow * 1024 + i * 128 + lane * 2); }
        float acc[16];
#pragma unroll
        for (int jg = 0; jg < 4; ++jg) {
#pragma unroll
            for (int jj = 0; jj < 4; ++jj) { const int j = jg * 4 + jj; float a = 0.f;
#pragma unroll
                for (int i = 0; i < 8; ++i) { const float2 w = *(const float2*)(ldsf + j * 1024 + i * 128 + lane * 2); a += __uint_as_float(hv[i] << 16) * w.x + __uint_as_float(hv[i] & 0xffff0000u) * w.y; }
                acc[j] = a; }
            __builtin_amdgcn_sched_barrier(0); }
        float v8[8], v4[4], v2[2], v1;
#pragma unroll
        for (int j = 0; j < 8; ++j) { const float send = (lane & 32) ? acc[j] : acc[j + 8], keep = (lane & 32) ? acc[j + 8] : acc[j]; v8[j] = keep + __shfl_xor(send, 32); }
#pragma unroll
        for (int j = 0; j < 4; ++j) { const float send = (lane & 16) ? v8[j] : v8[j + 4], keep = (lane & 16) ? v8[j + 4] : v8[j]; v4[j] = keep + __shfl_xor(send, 16); }
#pragma unroll
        for (int j = 0; j < 2; ++j) { const float send = (lane & 8) ? v4[j] : v4[j + 2], keep = (lane & 8) ? v4[j + 2] : v4[j]; v2[j] = keep + __shfl_xor(send, 8); }
        { const float send = (lane & 4) ? v2[0] : v2[1], keep = (lane & 4) ? v2[1] : v2[0]; v1 = keep + __shfl_xor(send, 4); }
        v1 += __shfl_xor(v1, 2); v1 += __shfl_xor(v1, 1);
        if ((lane & 3) == 0) BA[(size_t)row * 16 + ((lane >> 5) & 1) * 8 + ((lane >> 4) & 1) * 4 + ((lane >> 3) & 1) * 2 + ((lane >> 2) & 1)] = v1;
    }
    __syncthreads();
}

__device__ __forceinline__ void pool_load_w(const float* pw, float* ldsf, int tid) { for (int i = tid; i < 4096; i += 512) *(float4*)(ldsf + i * 4) = *(const float4*)(pw + i * 4); }
__device__ __forceinline__ void pool_task(const bf16_t* PP, const float* pscale, bf16_t* YP, float* ldsf, int task, int tid) {
    float* w = ldsf; float* p = ldsf + 4 * 4096; float* d = p + 80 * 64;
    {
        const int tile = task >> 2, g = task & 3;
        int seqbase, L, t0;
        if (tile < 512) { seqbase = (tile >> 6) * SEQ; L = SEQ; t0 = (tile & 63) * 64; } else { const int c = tile - 512; seqbase = ML + (c >> 2) * CTXL; L = CTXL; t0 = (c & 3) * 64; }
        for (int i = tid; i < 80 * 8; i += 512) { const int tt = i >> 3, c8 = (i & 7) * 8, tok = t0 - 8 + tt; float v[8];
            if (tok >= 0 && tok < L) unpack8(*(const uint4*)(PP + (size_t)(seqbase + tok) * 256 + g * 64 + c8), v);
            else {
#pragma unroll
                for (int j = 0; j < 8; ++j) v[j] = 0.f; }
            *(float4*)(p + tt * 64 + c8) = make_float4(v[0], v[1], v[2], v[3]); *(float4*)(p + tt * 64 + c8 + 4) = make_float4(v[4], v[5], v[6], v[7]); }
        __syncthreads();
        { const int hw = 1 << g, c = tid & 63, tb = (tid >> 6) * 8;
          int tg = t0 + tb, lo = max(tg - hw, 0), hi = min(tg + hw, L); float sacc = 0.f;
          for (int u = lo; u < hi; ++u) sacc += p[(u - t0 + 8) * 64 + c];
          d[tb * 65 + c] = sacc / (float)(hi - lo) - p[(tb + 8) * 64 + c];
#pragma unroll
          for (int k = 1; k < 8; ++k) { ++tg; const int nlo = max(tg - hw, 0), nhi = min(tg + hw, L);
              if (nlo > lo) sacc -= p[(lo - t0 + 8) * 64 + c];
              if (nhi > hi) sacc += p[(hi - t0 + 8) * 64 + c];
              lo = nlo; hi = nhi;
              d[(tb + k) * 65 + c] = sacc / (float)(hi - lo) - p[(tb + k + 8) * 64 + c]; } }
        __syncthreads();
        { const int t = tid >> 3, og = (tid & 7) * 8; float acc[8]; const float* wg = w + g * 4096;
#pragma unroll
          for (int j = 0; j < 8; ++j) acc[j] = 0.f;
#pragma unroll 8
          for (int i = 0; i < 64; ++i) { const float dv = d[t * 65 + i]; const float4 w0 = *(const float4*)(wg + i * 64 + og), w1 = *(const float4*)(wg + i * 64 + og + 4);
              acc[0] += dv * w0.x; acc[1] += dv * w0.y; acc[2] += dv * w0.z; acc[3] += dv * w0.w; acc[4] += dv * w1.x; acc[5] += dv * w1.y; acc[6] += dv * w1.z; acc[7] += dv * w1.w; }
#pragma unroll
          for (int j = 0; j < 8; ++j) acc[j] *= pscale[g * 64 + og + j];
          *(uint4*)(YP + (size_t)(seqbase + t0 + t) * 1024 + g * 64 + og) = pack8(acc); }
    }
}

__device__ __forceinline__ void norm_rope8(float* v, const float* gain, int d0, bool rope, int t, float outscale) {
    float ss = 0.f;
#pragma unroll
    for (int j = 0; j < 8; ++j) ss += v[j] * v[j];
    ss += __shfl_xor(ss, 1); ss += __shfl_xor(ss, 2); ss += __shfl_xor(ss, 4);
    const float rstd = rsqrtf(ss * (1.f / 64.f) + 1e-6f);
#pragma unroll
    for (int j = 0; j < 8; ++j) v[j] = v[j] * rstd * gain[d0 + j];
    if (rope) {
#pragma unroll
        for (int p = 0; p < 4; ++p) { const int i = (d0 >> 1) + p; const float pos = (float)(i < 16 ? (t >> 6) : (t & 63));
            const float inv = exp2f(-(float)(i & 15) * (13.287712379549449f / 16.f)); const float ang = pos * inv; const float c = __cosf(ang), s = __sinf(ang);
            const float x1 = v[2 * p], x2 = v[2 * p + 1]; v[2 * p] = x1 * c - x2 * s; v[2 * p + 1] = x1 * s + x2 * c; } }
#pragma unroll
    for (int j = 0; j < 8; ++j) v[j] *= outscale;
}
__device__ __forceinline__ void attn_prep_phase(const bf16_t* PAQ, const bf16_t* PKV, const float* qg, const float* kg, bf16_t* QA, bf16_t* KA, bf16_t* VA) {
    const int tid_ = ltid(), lane = tid_ & 63, bid_ = lbid(), G_ = lgdim(), wv8 = tid_ >> 6;
    int gw, nw, rend;
    if (G_ == 256) { nw = 1;
        if (bid_ < 128) { gw = (bid_ * 8 + wv8) * 9; rend = gw + 9; } else { gw = 9216 + ((bid_ - 128) * 8 + wv8) * 25; rend = gw + 25; } }
    else { gw = bid_ * 8 + wv8; nw = G_ * 8; rend = MT; }
    uint4 nq = make_uint4(0u, 0u, 0u, 0u), nk = nq;
    if (gw < rend) { nq = *(const uint4*)(PAQ + (size_t)gw * 512 + lane * 8); nk = *(const uint4*)(PKV + (size_t)gw * 256 + (lane & 31) * 8); }
    for (int row = gw; row < rend; row += nw) {
        const uint4 rq = nq, raw = nk; const int nrow = row + nw;
        if (nrow < rend) { nq = *(const uint4*)(PAQ + (size_t)nrow * 512 + lane * 8); nk = *(const uint4*)(PKV + (size_t)nrow * 256 + (lane & 31) * 8); }
        const bool lat = row < ML; const int b = lat ? (row >> 12) : ((row - ML) >> 8), t = lat ? (row & 4095) : ((row - ML) & 255);
        const int d0 = (lane & 7) * 8; float v[8];
        unpack8(rq, v);
        norm_rope8(v, qg, d0, lat, t, 0.125f * 1.4426950408889634f);
        *(uint4*)(QA + (size_t)row * 1024 + lane * 8) = pack8(v);
        unpack8(raw, v);
        norm_rope8(v, kg, d0, lat, t, 1.f);
        const size_t kvrow = (size_t)b * KVR + (lat ? CTXL + t : t);
        if (lane < 16) *(uint4*)(KA + kvrow * 128 + lane * 8) = pack8(v);
        else if (lane < 32) *(uint4*)(VA + kvrow * 128 + (lane - 16) * 8) = raw;
    }
}
struct DnBufs { bf16_t* U; bf16_t* W; bf16_t* QK; bf16_t* KT; bf16_t* QN; float* G; };
__device__ __forceinline__ float softplus_f(float x) { const float t = expf(fminf(x, 20.f)); const float sm = t * (1.f - t * (0.5f - t * (0.33333334f - 0.25f * t))); return x > 20.f ? x : (t < 0.0625f ? sm : logf(1.f + t)); }
__device__ __forceinline__ void dn_chunk_phase(const bf16_t* PQKV, const float* BA, const float* cw, const float* alog, const float* dtb, const DnBufs& D, float* ldsf) {
    const int tid = ltid();
    float* K = ldsf; float* V = ldsf + 4352; float* AT = ldsf + 8704; float* beta = ldsf + 16896; float* Gs = beta + 128; float* Q = ldsf + 17152;
    float* KK = ldsf + 21504; float* QKm = ldsf + 25856; float* RAW = ldsf + 21504; float* SOL = ldsf + 17152; float* CWL = ldsf + 35584;
    for (int task = lbid(); task < NB * 4 * NCH; task += lgdim()) {
        const int b = task / (4 * NCH), rem = task % (4 * NCH), h = rem / NCH, tc = rem % NCH;
        int seqbase, L, t0;
        if (tc < 4) { seqbase = ML + b * CTXL; L = CTXL; t0 = tc * 64; } else { seqbase = b * SEQ; L = SEQ; t0 = (tc - 4) * 64; }
        for (int i = tid; i < 68 * 24; i += 512) { const int tt = i / 24, c8 = i % 24, tok = t0 - 2 + tt; float v[8];
            if (tok >= 0 && tok < L) unpack8(*(const uint4*)(PQKV + (size_t)(seqbase + tok) * 768 + (c8 >> 3) * 256 + h * 64 + (c8 & 7) * 8), v);
            else {
#pragma unroll
                for (int j = 0; j < 8; ++j) v[j] = 0.f; }
            *(float4*)(RAW + tt * 192 + c8 * 8) = make_float4(v[0], v[1], v[2], v[3]); *(float4*)(RAW + tt * 192 + c8 * 8 + 4) = make_float4(v[4], v[5], v[6], v[7]); }
        for (int i = tid; i < 960; i += 512) { const int j = i / 192, ch = i % 192; CWL[i] = cw[j * 768 + (ch >> 6) * 256 + h * 64 + (ch & 63)]; }
        __syncthreads();
        for (int i = tid; i < 64 * 192; i += 512) { const int r = i / 192, ch = i % 192, which = ch >> 6, dd = ch & 63; float acc = 0.f;
#pragma unroll
            for (int j = 0; j < 5; ++j) acc += RAW[(r + j) * 192 + ch] * CWL[j * 192 + ch];
            float* dst = which == 0 ? Q : (which == 1 ? K : V);
            dst[r * 68 + dd] = acc * __builtin_amdgcn_rcpf(1.f + __expf(-acc)); }
        __syncthreads();
        { const int row = tid >> 2, part = tid & 3; float* p = (row < 64 ? Q : K) + (row & 63) * 68 + part * 16; float ss = 0.f;
#pragma unroll
          for (int j = 0; j < 16; ++j) ss += p[j] * p[j];
          ss += __shfl_xor(ss, 1); ss += __shfl_xor(ss, 2);
          const float sc = rsqrtf(ss + 1e-6f) * (row < 64 ? 0.125f : 1.f);
#pragma unroll
          for (int j = 0; j < 16; ++j) p[j] *= sc; }
        if (tid < 128) { const int dir = tid >> 6, r = tid & 63, tok = dir ? 63 - r : r; const float* ba = BA + (size_t)(seqbase + t0 + tok) * 16;
            const float bb = 1.f / (1.f + expf(-ba[dir * 4 + h]));
            float gg = -expf(alog[dir * 4 + h]) * softplus_f(ba[8 + dir * 4 + h] + dtb[dir * 4 + h]);
#pragma unroll
            for (int o = 1; o < 64; o <<= 1) { const float up = __shfl_up(gg, o); if (r >= o) gg += up; }
            beta[dir * 64 + r] = bb; Gs[dir * 64 + r] = gg; }
        __syncthreads();
        { typedef float f32x16_t __attribute__((ext_vector_type(16)));
          const int wv = tid >> 6, ln = tid & 63, r32 = ln & 31, hi = ln >> 5, prod = wv >> 2, bi = (wv >> 1) & 1, bj = wv & 1;
          const float* Ar = (prod ? Q : K) + (32 * bi + r32) * 68 + hi; const float* Br = K + (32 * bj + r32) * 68 + hi;
          f32x16_t acc;
#pragma unroll
          for (int r = 0; r < 16; ++r) acc[r] = 0.f;
#pragma unroll 8
          for (int s2 = 0; s2 < 32; ++s2) acc = __builtin_amdgcn_mfma_f32_32x32x2f32(Ar[2 * s2], Br[2 * s2], acc, 0, 0, 0);
          float* dst = (prod ? QKm : KK) + (32 * bi + 4 * hi) * 68 + 32 * bj + r32;
#pragma unroll
          for (int r = 0; r < 16; ++r) dst[((r & 3) + 8 * (r >> 2)) * 68] = acc[r]; }
        __syncthreads();
        const int cid0 = ((0 * NB + b) * 4 + h) * NCH + tc, cid1 = ((1 * NB + b) * 4 + h) * NCH + (tc < 4 ? 3 - tc : 71 - tc);
        for (int idx = tid; idx < 2 * 4096; idx += 512) { const int dir = idx >> 12, rp = (idx >> 6) & 63, r = idx & 63; float v = 0.f;
            if (rp < r) { const int ti = dir ? 63 - r : r, tj = dir ? 63 - rp : rp; v = beta[dir * 64 + r] * KK[ti * 68 + tj] * __expf(Gs[dir * 64 + r] - Gs[dir * 64 + rp]); }
            AT[dir * 4096 + rp * 64 + r] = v; }
        for (int idx = tid; idx < 2 * 64 * 8; idx += 512) { const int dir = idx >> 9, r = (idx >> 3) & 63, p8 = idx & 7; float v[8];
#pragma unroll
            for (int j = 0; j < 8; ++j) { const int rp = unpermk(p8 * 8 + j); v[j] = 0.f;
                if (rp <= r) { const int ti = dir ? 63 - r : r, tj = dir ? 63 - rp : rp; v[j] = QKm[ti * 68 + tj] * __expf(Gs[dir * 64 + r] - Gs[dir * 64 + rp]); } }
            *(uint4*)(D.QK + (size_t)(dir ? cid1 : cid0) * 4096 + r * 64 + p8 * 8) = pack8(v); }
        for (int item = tid; item < 1024; item += 512) { const int dir = item >> 9, dk = (item >> 3) & 63, p8 = item & 7; float v[8];
#pragma unroll
            for (int j = 0; j < 8; ++j) { const int cc = unpermk(p8 * 8 + j), tok = dir ? 63 - cc : cc; v[j] = K[tok * 68 + dk]; }
            *(uint4*)(D.KT + (size_t)(dir ? cid1 : cid0) * 4096 + dk * 64 + p8 * 8) = pack8(v); }
        { const int tok = tid >> 3, p8 = tid & 7; float v[8];
#pragma unroll
          for (int j = 0; j < 8; ++j) v[j] = Q[tok * 68 + unpermk(p8 * 8 + j)];
          *(uint4*)(D.QN + (size_t)(seqbase + t0 + tok) * 256 + h * 64 + p8 * 8) = pack8(v); }
        if (tid < 128) { const int dir = tid >> 6, r = tid & 63; D.G[(size_t)(dir ? cid1 : cid0) * 64 + r] = Gs[dir * 64 + r]; }
        __syncthreads();
        for (int idx = tid; idx < 2 * 64 * 128; idx += 512) { const int dir = idx >> 13, r = (idx >> 7) & 63, c = idx & 127, tok = dir ? 63 - r : r; const float bt = beta[dir * 64 + r];
            SOL[dir * 9216 + r * 144 + c] = c < 64 ? V[tok * 68 + c] * bt : K[tok * 68 + (c - 64)] * bt * __expf(Gs[dir * 64 + r]); }
        __syncthreads();
        { const int col = tid >> 1, hh = tid & 1, dir = col >> 7, c = col & 127; float* S = SOL + dir * 9216 + c; const float* A = AT + dir * 4096;
#pragma unroll 1
            for (int rb = 0; rb < 8; ++rb) { const int r0 = 8 * rb; float a[8];
                if (rb == 2 || rb == 6) {
                    const int ln = tid & 63, i16 = ln & 15, kq = ln >> 4, cb = 32 * ((tid >> 6) & 3), rbase = 8 * rb, kbase = rbase - 16; float* Sd = SOL + dir * 9216 + cb + i16;
#pragma unroll
                    for (int nb = 0; nb < 2; ++nb) { f32x4 acc4 = (f32x4){0.f, 0.f, 0.f, 0.f};
#pragma unroll
                        for (int ks = 0; ks < 4; ++ks) acc4 = __builtin_amdgcn_mfma_f32_16x16x4f32(A[(kbase + 4 * ks + kq) * 64 + rbase + i16], Sd[(kbase + 4 * ks + kq) * 144 + 16 * nb], acc4, 0, 0, 0);
#pragma unroll
                        for (int jj = 0; jj < 4; ++jj) Sd[(rbase + 4 * kq + jj) * 144 + 16 * nb] -= acc4[jj]; } }
                if (rb == 4) {
                    typedef float f32x16_t __attribute__((ext_vector_type(16)));
                    const int ln = tid & 63, r32 = ln & 31, hi2 = ln >> 5, cb = 32 * ((tid >> 6) & 3); float* Sd = SOL + dir * 9216 + cb + r32;
                    f32x16_t acc;
#pragma unroll
                    for (int r = 0; r < 16; ++r) acc[r] = 0.f;
#pragma unroll 8
                    for (int s2 = 0; s2 < 16; ++s2) acc = __builtin_amdgcn_mfma_f32_32x32x2f32(A[(2 * s2 + hi2) * 64 + 32 + r32], Sd[(2 * s2 + hi2) * 144], acc, 0, 0, 0);
#pragma unroll
                    for (int r = 0; r < 16; ++r) Sd[(32 + (r & 3) + 8 * (r >> 2) + 4 * hi2) * 144] -= acc[r]; }
#pragma unroll
                for (int k = 0; k < 8; ++k) a[k] = 0.f;
                for (int j = hh + 16 * (rb >> 1); j < r0; j += 8) {
                    float sv[4]; float4 lo[4], hi[4];
#pragma unroll
                    for (int k = 0; k < 4; ++k) { sv[k] = S[(j + 2 * k) * 144]; lo[k] = *(const float4*)(A + (j + 2 * k) * 64 + r0); hi[k] = *(const float4*)(A + (j + 2 * k) * 64 + r0 + 4); }
#pragma unroll
                    for (int k = 0; k < 4; ++k) { a[0] += lo[k].x * sv[k]; a[1] += lo[k].y * sv[k]; a[2] += lo[k].z * sv[k]; a[3] += lo[k].w * sv[k];
                        a[4] += hi[k].x * sv[k]; a[5] += hi[k].y * sv[k]; a[6] += hi[k].z * sv[k]; a[7] += hi[k].w * sv[k]; } }
                float x[8]; float cf[7][8];
#pragma unroll
                for (int k = 0; k < 8; ++k) x[k] = S[(r0 + k) * 144];
#pragma unroll
                for (int i = 0; i < 7; ++i) { const float4 l4 = *(const float4*)(A + (r0 + i) * 64 + r0), h4 = *(const float4*)(A + (r0 + i) * 64 + r0 + 4);
                    cf[i][0] = l4.x; cf[i][1] = l4.y; cf[i][2] = l4.z; cf[i][3] = l4.w; cf[i][4] = h4.x; cf[i][5] = h4.y; cf[i][6] = h4.z; cf[i][7] = h4.w; }
#pragma unroll
                for (int k = 0; k < 8; ++k) a[k] += __shfl_xor(a[k], 1);
#pragma unroll
                for (int k = 0; k < 8; ++k) { float v = x[k] - a[k];
#pragma unroll
                    for (int i = 0; i < k; ++i) v -= cf[i][k] * x[i];
                    x[k] = v; }
                if (hh == 0) {
#pragma unroll
                    for (int k = 0; k < 8; ++k) S[(r0 + k) * 144] = x[k]; } } }
        __syncthreads();
        for (int item = tid; item < 2048; item += 512) { const int dir = item >> 10, s4 = (item >> 8) & 3, mb = (item >> 6) & 3, q = (item >> 4) & 3, n = item & 15;
            const float* S = SOL + dir * 9216 + (16 * mb + 4 * q) * 144 + 16 * s4 + n; uint2 o; o.x = pk2(S[0], S[144]); o.y = pk2(S[288], S[432]);
            *(uint2*)(D.U + (size_t)(dir ? cid1 : cid0) * 4096 + ((s4 * 4 + mb) * 64 + q * 16 + n) * 4) = o; }
        for (int item = tid; item < 1024; item += 512) { const int dir = item >> 9, r = (item >> 3) & 63, p8 = item & 7; float v[8];
#pragma unroll
            for (int j = 0; j < 8; ++j) v[j] = -SOL[dir * 9216 + r * 144 + 64 + unpermk(p8 * 8 + j)];
            *(uint4*)(D.W + (size_t)(dir ? cid1 : cid0) * 4096 + r * 64 + p8 * 8) = pack8(v); }
        __syncthreads();
    }
}

__device__ __forceinline__ bf16x8 pack_bb(const f32x4 a, const f32x4 b) {
    uint4 r; r.x = pk2(a[0], a[1]); r.y = pk2(a[2], a[3]); r.z = pk2(b[0], b[1]); r.w = pk2(b[2], b[3]); return __builtin_bit_cast(bf16x8, r);
}
#define SCAN_REGION 35328
__device__ __forceinline__ void dn_scan_issue(const DnBufs& D, int dir, int b, int h, int s, int nn, size_t cbase, int lane, PG8_LAS unsigned char* L) {
    const int q = lane >> 4, n = lane & 15;
    const size_t cid = cbase + nn;
    const int tc = dir ? (nn < 4 ? 3 - nn : 71 - nn) : nn;
    const int rowbase = tc < 4 ? ML + b * CTXL + tc * 64 : b * SEQ + (tc - 4) * 64;
    const bf16_t* Wp = D.W + cid * 4096 + n * 64 + q * 8; const bf16_t* QKp = D.QK + cid * 4096 + n * 64 + q * 8; const bf16_t* KTp = D.KT + cid * 4096 + n * 64 + q * 8;
    const bf16_t* Up = D.U + cid * 4096 + (s * 4 * 64 + lane) * 4;
#pragma unroll
    for (int mb = 0; mb < 4; ++mb) {
        const int r = 16 * mb + n; const bf16_t* Np = D.QN + (size_t)(rowbase + (dir ? 63 - r : r)) * 256 + h * 64 + q * 8;
#pragma unroll
        for (int ks = 0; ks < 2; ++ks) { const int f = mb * 2 + ks;
            __builtin_amdgcn_global_load_lds((const unsigned*)(Wp + mb * 1024 + ks * 32), (PG8_LAS unsigned*)(L + f * 1024), 16, 0, 0);
            __builtin_amdgcn_global_load_lds((const unsigned*)(QKp + mb * 1024 + ks * 32), (PG8_LAS unsigned*)(L + 8192 + f * 1024), 16, 0, 0);
            __builtin_amdgcn_global_load_lds((const unsigned*)(KTp + mb * 1024 + ks * 32), (PG8_LAS unsigned*)(L + 16384 + f * 1024), 16, 0, 0);
            __builtin_amdgcn_global_load_lds((const unsigned*)(Np + ks * 32), (PG8_LAS unsigned*)(L + 24576 + f * 1024), 16, 0, 0); }
        __builtin_amdgcn_global_load_lds((const unsigned*)(Up + mb * 256), (PG8_LAS unsigned*)(L + 32768 + (mb * 2) * 256), 4, 0, 0);
        __builtin_amdgcn_global_load_lds((const unsigned*)(Up + mb * 256 + 2), (PG8_LAS unsigned*)(L + 32768 + (mb * 2 + 1) * 256), 4, 0, 0); }
    __builtin_amdgcn_global_load_lds((const unsigned*)(D.G + cid * 64 + lane), (PG8_LAS unsigned*)(L + 34816), 4, 0, 0);
}
__device__ __forceinline__ void dn_scan_chain(const DnBufs& D, float* OF, float* OB, int chain, int lane, PG8_LAS unsigned char* L) {
    const int dir = chain >> 7, b = (chain >> 4) & 7, h = (chain >> 2) & 3, s = chain & 3, q = lane >> 4, n = lane & 15;
    float* O = dir ? OB : OF;
    f32x4 S[4];
#pragma unroll
    for (int i = 0; i < 4; ++i) S[i] = (f32x4){0.f, 0.f, 0.f, 0.f};
    const size_t cbase = (size_t)((dir * NB + b) * 4 + h) * NCH;
    dn_scan_issue(D, dir, b, h, s, 0, cbase, lane, L);
    for (int nn = 0; nn < NCH; ++nn) {
        const int tc = dir ? (nn < 4 ? 3 - nn : 71 - nn) : nn;
        const int rowbase = tc < 4 ? ML + b * CTXL + tc * 64 : b * SEQ + (tc - 4) * 64;
        asm volatile("s_waitcnt vmcnt(0)" ::: "memory");
        bf16x8 wf[4][2], qf[4][2], kf[4][2], nf[4][2]; f32x4 vn[4], g4[4];
#pragma unroll
        for (int mb = 0; mb < 4; ++mb) {
#pragma unroll
            for (int ks = 0; ks < 2; ++ks) { const int f = mb * 2 + ks;
                wf[mb][ks] = *(const PG8_LAS bf16x8*)(L + f * 1024 + lane * 16); qf[mb][ks] = *(const PG8_LAS bf16x8*)(L + 8192 + f * 1024 + lane * 16);
                kf[mb][ks] = *(const PG8_LAS bf16x8*)(L + 16384 + f * 1024 + lane * 16); nf[mb][ks] = *(const PG8_LAS bf16x8*)(L + 24576 + f * 1024 + lane * 16); }
            const unsigned u0 = *(const PG8_LAS unsigned*)(L + 32768 + (mb * 2) * 256 + lane * 4), u1 = *(const PG8_LAS unsigned*)(L + 32768 + (mb * 2 + 1) * 256 + lane * 4);
            vn[mb] = (f32x4){__uint_as_float(u0 << 16), __uint_as_float(u0 & 0xffff0000u), __uint_as_float(u1 << 16), __uint_as_float(u1 & 0xffff0000u)};
            g4[mb] = *(const PG8_LAS f32x4*)(L + 34816 + (16 * mb + 4 * q) * 4); }
        const float glast = *(const PG8_LAS float*)(L + 34816 + 63 * 4);
        asm volatile("s_waitcnt lgkmcnt(0)" ::: "memory");
        bf16x8 Sb[2] = {pack_bb(S[0], S[1]), pack_bb(S[2], S[3])};
        f32x4 o1[4], o2[4];
#pragma unroll
        for (int mb = 0; mb < 4; ++mb) {
            vn[mb] = __builtin_amdgcn_mfma_f32_16x16x32_bf16(wf[mb][0], Sb[0], vn[mb], 0, 0, 0); vn[mb] = __builtin_amdgcn_mfma_f32_16x16x32_bf16(wf[mb][1], Sb[1], vn[mb], 0, 0, 0);
            o1[mb] = __builtin_amdgcn_mfma_f32_16x16x32_bf16(nf[mb][0], Sb[0], (f32x4){0.f, 0.f, 0.f, 0.f}, 0, 0, 0); o1[mb] = __builtin_amdgcn_mfma_f32_16x16x32_bf16(nf[mb][1], Sb[1], o1[mb], 0, 0, 0); }
        __builtin_amdgcn_sched_barrier(0);
        if (nn + 1 < NCH) dn_scan_issue(D, dir, b, h, s, nn + 1, cbase, lane, L);
        __builtin_amdgcn_sched_barrier(0);
        bf16x8 Vb[2] = {pack_bb(vn[0], vn[1]), pack_bb(vn[2], vn[3])};
        f32x4 e[4];
#pragma unroll
        for (int mb = 0; mb < 4; ++mb)
#pragma unroll
            for (int j = 0; j < 4; ++j) e[mb][j] = __expf(glast - g4[mb][j]);
        bf16x8 Vs[2] = {pack_bb(vn[0] * e[0], vn[1] * e[1]), pack_bb(vn[2] * e[2], vn[3] * e[3])};
        const float gl = __expf(glast);
#pragma unroll
        for (int mb = 0; mb < 4; ++mb) {
            o2[mb] = __builtin_amdgcn_mfma_f32_16x16x32_bf16(qf[mb][0], Vb[0], (f32x4){0.f, 0.f, 0.f, 0.f}, 0, 0, 0); o2[mb] = __builtin_amdgcn_mfma_f32_16x16x32_bf16(qf[mb][1], Vb[1], o2[mb], 0, 0, 0);
            S[mb] = S[mb] * gl; S[mb] = __builtin_amdgcn_mfma_f32_16x16x32_bf16(kf[mb][0], Vs[0], S[mb], 0, 0, 0); S[mb] = __builtin_amdgcn_mfma_f32_16x16x32_bf16(kf[mb][1], Vs[1], S[mb], 0, 0, 0); }
#pragma unroll
        for (int mb = 0; mb < 4; ++mb)
#pragma unroll
            for (int j = 0; j < 4; ++j) { const int r = 16 * mb + 4 * q + j;
                O[(size_t)(rowbase + (dir ? 63 - r : r)) * 256 + h * 64 + s * 16 + n] = __expf(g4[mb][j]) * o1[mb][j] + o2[mb][j]; }
    }
    asm volatile("s_waitcnt vmcnt(0)" ::: "memory");
}

__device__ __forceinline__ void dn_out_phase(const float* OF, const float* OB, const bf16_t* PZ, const float* gn, bf16_t* YD) {
    const int tid_ = ltid(), lane = tid_ & 63, gw = lbid() * 8 + (tid_ >> 6), nw = lgdim() * 8;
    const float4 g = *(const float4*)(gn + (lane & 15) * 4);
    float4 na = make_float4(0.f, 0.f, 0.f, 0.f), nb = na; uint2 nz = make_uint2(0u, 0u);
    if (gw < MT) { na = *(const float4*)(OF + (size_t)gw * 256 + lane * 4); nb = *(const float4*)(OB + (size_t)gw * 256 + lane * 4); nz = *(const uint2*)(PZ + (size_t)gw * 256 + lane * 4); }
    for (int row = gw; row < MT; row += nw) {
        const float4 a = na, bq = nb; const uint2 zz = nz; const int nrow = row + nw;
        if (nrow < MT) { na = *(const float4*)(OF + (size_t)nrow * 256 + lane * 4); nb = *(const float4*)(OB + (size_t)nrow * 256 + lane * 4); nz = *(const uint2*)(PZ + (size_t)nrow * 256 + lane * 4); }
#ifdef PROBE_O1
        const float o0 = 1.f + 0.f * (a.x + bq.x), o1 = 1.f, o2 = 1.f, o3 = 1.f;
#else
        const float o0 = a.x + bq.x, o1 = a.y + bq.y, o2 = a.z + bq.z, o3 = a.w + bq.w;
#endif
        float ss = o0 * o0 + o1 * o1 + o2 * o2 + o3 * o3;
        ss += __shfl_xor(ss, 1); ss += __shfl_xor(ss, 2); ss += __shfl_xor(ss, 4); ss += __shfl_xor(ss, 8);
        const float rstd = rsqrtf(ss * (1.f / 64.f) + 1e-6f);
        const float z0 = __uint_as_float(zz.x << 16), z1 = __uint_as_float(zz.x & 0xffff0000u), z2 = __uint_as_float(zz.y << 16), z3 = __uint_as_float(zz.y & 0xffff0000u);
        uint2 o; o.x = pk2(o0 * rstd * g.x * pg8::fsilu(z0), o1 * rstd * g.y * pg8::fsilu(z1)); o.y = pk2(o2 * rstd * g.z * pg8::fsilu(z2), o3 * rstd * g.w * pg8::fsilu(z3));
        *(uint2*)(YD + (size_t)row * 1024 + lane * 4) = o;
    }
}

#define XB_TMO      128
#define XB_XCNT(j)  (256  + 64 * (j))
#define XB_XSUB(j)  (1280 + 64 * (j))
#define XB_XGEN(j)  (2304 + 64 * (j))
#define XB_TOP      3328
#define XB_TOPGEN   3392
#define XCD_BAR_WORDS 3456
#define XB_SPIN_CAP (1u << 18)
#define XLAS __attribute__((address_space(3)))

__device__ __forceinline__ unsigned xb_ld(unsigned* p)              { return __hip_atomic_load(p, __ATOMIC_RELAXED, __HIP_MEMORY_SCOPE_AGENT); }
__device__ __forceinline__ unsigned xb_add(unsigned* p, unsigned v) { return __hip_atomic_fetch_add(p, v, __ATOMIC_RELAXED, __HIP_MEMORY_SCOPE_AGENT); }
__device__ __forceinline__ unsigned xb_xcc_id() { return (unsigned)__builtin_amdgcn_s_getreg((3 << 11) | 20) & 0xFu; }
#define XB_SPIN(cond, bar) do { unsigned _sp = 0; while (cond) { __builtin_amdgcn_s_sleep(1); \
    if ((++_sp & 255u) == 0u) { if (xb_ld(&(bar)[XB_TMO])) break; if (_sp > XB_SPIN_CAP) { atomicAdd(&(bar)[XB_TMO], 1u); break; } } } } while (0)

struct XcdBarrier {
    unsigned* bar; unsigned x;
    volatile XLAS unsigned* st;
};

__device__ __forceinline__ XcdBarrier xcd_barrier_post(unsigned* bar, volatile XLAS unsigned* st) {
    XcdBarrier b; b.bar = bar; b.x = xb_xcc_id(); b.st = st;
    if (threadIdx.x == 0) (void)xb_add(&bar[XB_XCNT(b.x)], 1u);
    return b;
}
__device__ __forceinline__ void xcd_barrier_complete(unsigned* bar, unsigned x, unsigned& nloc, unsigned& nx) {
    const unsigned G = gridDim.x * gridDim.y * gridDim.z;
    unsigned sum, cnt, mine, sp = 0u;
    for (;;) {
        sum = 0u; cnt = 0u; mine = 0u;
#pragma unroll
        for (unsigned j = 0; j < 16; ++j) { const unsigned c = xb_ld(&bar[XB_XCNT(j)]); sum += c; cnt += (c > 0u) ? 1u : 0u; mine = (j == x) ? c : mine; }
        if (sum == G) break;
        __builtin_amdgcn_s_sleep(1);
        if ((++sp & 255u) == 0u) { if (xb_ld(&bar[XB_TMO])) break; if (sp > XB_SPIN_CAP) { atomicAdd(&bar[XB_TMO], 1u); break; } }
    }
    nloc = mine > 0u ? mine : 1u; nx = cnt > 0u ? cnt : 1u;
}

__device__ __forceinline__ void xcd_barrier(const XcdBarrier& b) {
    asm volatile("s_waitcnt vmcnt(0)" ::: "memory");
    __syncthreads();
    if (threadIdx.x == 0) {
        unsigned* bar = b.bar;
        __builtin_amdgcn_s_waitcnt(0);
        unsigned nloc = b.st[0], nx = b.st[1];
        if (nloc == 0u) { xcd_barrier_complete(bar, b.x, nloc, nx); b.st[0] = nloc; b.st[1] = nx; }
        const unsigned old = xb_add(&bar[XB_XSUB(b.x)], 1u);
        const unsigned gen = old / nloc;
        if (old + 1u == (gen + 1u) * nloc) {
            __builtin_amdgcn_fence(__ATOMIC_RELEASE, "agent");
            asm volatile("s_waitcnt vmcnt(0)" ::: "memory");
            const unsigned og = xb_add(&bar[XB_TOP], 1u);
            const unsigned tg = og / nx;
            if (og + 1u == (tg + 1u) * nx) xb_add(&bar[XB_TOPGEN], 1u);
            else XB_SPIN(xb_ld(&bar[XB_TOPGEN]) == tg, bar);
            __builtin_amdgcn_fence(__ATOMIC_ACQUIRE, "agent");
            xb_add(&bar[XB_XGEN(b.x)], 1u);
            asm volatile("s_waitcnt vmcnt(0)" ::: "memory");
        } else {
            XB_SPIN(xb_ld(&bar[XB_XGEN(b.x)]) == gen, bar);
            __builtin_amdgcn_fence(__ATOMIC_ACQUIRE, "agent");
            asm volatile("s_waitcnt vmcnt(0)" ::: "memory");
        }
    }
    __syncthreads();
}

__global__ void __launch_bounds__(512, 2) fwd_mega(Args a) {
    extern __shared__ __attribute__((aligned(16))) unsigned char lds[];
    cg::grid_group grid = cg::this_grid();
    float* ldsf = (float*)lds;
    unsigned char* ws = a.ws;
    float* MOD = (float*)(ws + WS_MOD); float* XC = (float*)(ws + WS_XC); bf16_t* H = (bf16_t*)(ws + WS_H);
    bf16_t* ACT = (bf16_t*)(ws + WS_ACT); float* PART = (float*)(ws + WS_DNU);
    volatile XLAS unsigned* xst = (volatile XLAS unsigned*)((XLAS unsigned char*)lds + 146432);
    if (threadIdx.x == 0) { xst[0] = 0u; xst[1] = 0u; }
    __syncthreads();
    (void)xcd_barrier_post((unsigned*)(ws + WS_BAR), xst);
#define GSYNC() do { XcdBarrier xb_; xb_.bar = (unsigned*)(ws + WS_BAR); xb_.x = xb_xcc_id(); xb_.st = xst; xcd_barrier(xb_); } while (0)
    for (size_t i = (size_t)blockIdx.x * 512 + threadIdx.x; i < (size_t)MC * DM / 4; i += (size_t)gridDim.x * 512) ((float4*)XC)[i] = ((const float4*)a.in[I_CTX])[i];
    mods_phase(a, ldsf, MOD);
    weights_phase(a, 0, ws, ldsf, true);
    if (a.ws == nullptr) grid.sync();
    GSYNC();
    for (int l = 0; l < DEPTH; ++l) {
        const int G = lgdim(), bid = lbid();
        const float* xl_in = l == 0 ? a.in[I_X] : a.out; const float* xc_in = l == 0 ? a.in[I_CTX] : XC;
        const float* modl = MOD + (size_t)l * 9 * MODW;
        if (l > 0) weights_phase(a, l, ws, ldsf, G != 256);
        norm_phase(xl_in, xc_in, a.in[I_NF1] + l * 1024, modl, 0, H, MT, XC, PART, l > 0 ? 8 : 0);
        GSYNC();
        { pg8::Gemm g{H, (const bf16_t*)(ws + WS_W1IN), MT, 5632, 1024}; pg8::StaticOrder S; S.init(MT, 5632, G, bid); pg8::EpiSwiglu E{ACT};
          pg8::gemm_phase<pg8::EpiSwiglu, pg8::StaticOrder, true, true>((PG8_LAS unsigned char*)lds, g, S, E); }
        GSYNC();
        { pg8::Gemm g{ACT, (const bf16_t*)(ws + WS_W1OUT), MT, 1024, 2816}; pg8::SplitOrder S; S.init(ML, MT, 1024, 2816, G, bid, 8); pg8::EpiResid E{xl_in, a.out, XC, modl + 2 * 1024, PART, 0.5f};
          pg8::gemm_phase<pg8::EpiResid, pg8::SplitOrder, true, true>((PG8_LAS unsigned char*)lds, g, S, E); }
        GSYNC();
        norm_phase(a.out, XC, a.in[I_NMIX] + l * 1024, modl, 3, H, MT, XC, PART, 8);
        GSYNC();
        { pg8::Gemm g{H, (const bf16_t*)(ws + WS_WIN), MT, 5120, 1024}; pg8::StaticOrder S; S.init(MT, 5120, G, bid);
          pg8::EpiProj E{(bf16_t*)(ws + WS_PPOOL), (bf16_t*)(ws + WS_PQKV), (bf16_t*)(ws + WS_PZ), (bf16_t*)(ws + WS_PAQ), (bf16_t*)(ws + WS_PKV), (bf16_t*)(ws + WS_PGATE)};
          pg8::gemm_phase<pg8::EpiProj, pg8::StaticOrder, true, true>((PG8_LAS unsigned char*)lds, g, S, E); }
        if constexpr (EN_MASK & 2) ba_phase(a.in[I_WIN] + (size_t)l * 1024 * INC, H, (float*)(ws + WS_BA), ldsf);
        GSYNC();
        const DnBufs D{(bf16_t*)(ws + WS_DNU), (bf16_t*)(ws + WS_DNW), (bf16_t*)(ws + WS_DNQK), (bf16_t*)(ws + WS_DNKT), (bf16_t*)(ws + WS_DNQN), (float*)(ws + WS_DNG)};
        for (int rep_ = 0; rep_ < DBL_CHUNK; ++rep_) dn_chunk_phase((const bf16_t*)(ws + WS_PQKV), (const float*)(ws + WS_BA), a.in[I_CONV] + l * 5 * 768, a.in[I_ALOG] + l * 8, a.in[I_DTB] + l * 8, D, ldsf);
        if constexpr (EN_MASK & 16) attn_prep_phase((const bf16_t*)(ws + WS_PAQ), (const bf16_t*)(ws + WS_PKV), a.in[I_QN] + l * 64, a.in[I_KN] + l * 64, (bf16_t*)(ws + WS_Y) + 512, (bf16_t*)(ws + WS_KATT), (bf16_t*)(ws + WS_VATT));
        GSYNC();
        { using abf = attn_body::bf16; abf* QA = (abf*)(ws + WS_Y) + 512; const abf* KA = (const abf*)(ws + WS_KATT); const abf* VA = (const abf*)(ws + WS_VATT);
          const int t_ = ltid(), wv_ = __builtin_amdgcn_readfirstlane(t_ >> 6);
          if (wv_ < 4) for (int chain = bid * 4 + wv_; chain < 256; chain += G * 4) dn_scan_chain(D, (float*)(ws + WS_OF), (float*)(ws + WS_OB), chain, t_ & 63, (PG8_LAS unsigned char*)lds + wv_ * SCAN_REGION);
          unsigned* ctr = (unsigned*)(ws + WS_CTR) + l; volatile unsigned* slot = (volatile unsigned*)(ldsf + 36600);
          const int natt = (l == DEPTH - 1) ? 1024 : 1024 + 64, npool = ((l == DEPTH - 1) ? 512 : 544) * 4; bool wres = false;
          for (;;) {
              __syncthreads();
              if (t_ == 0) *slot = atomicAdd(ctr, 1u);
              __syncthreads();
              const int id = (int)__builtin_amdgcn_readfirstlane(*slot);
              if (id >= natt + npool) break;
              if (id >= natt) {
                  if (!wres) { pool_load_w(a.in[I_POOLW] + (size_t)l * 4 * 4096, ldsf, t_); wres = true; }
                  pool_task((const bf16_t*)(ws + WS_PPOOL), a.in[I_POOLS] + l * 256, (bf16_t*)(ws + WS_Y), ldsf, id - natt, t_);
                  continue; }
              int b, h, NT; abf* Qu;
              if (id < 1024) { b = id >> 7; h = (id >> 4) & 7; Qu = QA + ((size_t)b * SEQ + (id & 15) * 256) * 1024 + h * 64; NT = KVR / 64; }
              else { const int c = id - 1024; b = c >> 3; h = c & 7; Qu = QA + ((size_t)ML + b * CTXL) * 1024 + h * 64; NT = CTXL / 64; }
              attn_body::attn_unit<8>(Qu, KA + (size_t)b * KVR * 128 + (h >> 2) * 64, VA + (size_t)b * KVR * 128 + (h >> 2) * 64, Qu, NT, (char*)lds); } }
        GSYNC();
        if constexpr (EN_MASK & 128) dn_out_phase((const float*)(ws + WS_OF), (const float*)(ws + WS_OB), (const bf16_t*)(ws + WS_PZ), a.in[I_DNN] + l * 64, (bf16_t*)(ws + WS_Y) + 256);
        GSYNC();
        const int MR = (l == DEPTH - 1) ? ML : MT;
        for (int rep_ = 0; rep_ < DBL_MERGE; ++rep_) { pg8::Gemm g{(const bf16_t*)(ws + WS_Y), (const bf16_t*)(ws + WS_WA), MR, 1024, 1024}; pg8::MergeOrder S; S.init(MR, 1024, G, bid);
          pg8::EpiGate E{(const bf16_t*)(ws + WS_PGATE), (bf16_t*)(ws + WS_MBF)};
          pg8::gemm_phase<pg8::EpiGate, pg8::MergeOrder, true, true>((PG8_LAS unsigned char*)lds, g, S, E); }
        if (G == 256 && l < DEPTH - 1 && bid >= 32) {
            const int t_ = ltid(), ln = l + 1;
            for (int t = bid - 32; t < 3392; t += 224) {
                if (t < 1408) tconv_tile(a.in[I_F1IN] + (size_t)ln * 1024 * 5632, 5632, 1024, 1, (bf16_t*)(ws + WS_W1IN), t, ldsf, t_);
                else if (t < 2112) tconv_tile(a.in[I_F1OUT] + (size_t)ln * 2816 * 1024, 1024, 2816, 0, (bf16_t*)(ws + WS_W1OUT), t - 1408, ldsf, t_);
                else tconv_tile(a.in[I_WIN] + (size_t)ln * 1024 * INC, INC, 1024, 2, (bf16_t*)(ws + WS_WIN), t - 2112, ldsf, t_); } }
        GSYNC();
        { pg8::Gemm g{(const bf16_t*)(ws + WS_MBF), (const bf16_t*)(ws + WS_WOUT), MR, 1024, 1024}; pg8::SplitOrder S; S.init(ML, MR, 1024, 1024, G, bid, 4); pg8::EpiResid E{a.out, a.out, XC, modl + 5 * 1024, PART, 1.0f};
          pg8::gemm_phase<pg8::EpiResid, pg8::SplitOrder, true, true>((PG8_LAS unsigned char*)lds, g, S, E); }
        GSYNC();
        norm_phase(a.out, XC, a.in[I_NF2] + l * 1024, modl, 6, H, MR, XC, PART, 4);
        GSYNC();
        { pg8::Gemm g{H, (const bf16_t*)(ws + WS_W2IN), MR, 5632, 1024}; pg8::StaticOrder S; S.init(MR, 5632, G, bid); pg8::EpiSwiglu E{ACT};
          pg8::gemm_phase<pg8::EpiSwiglu, pg8::StaticOrder, true, true>((PG8_LAS unsigned char*)lds, g, S, E); }
        GSYNC();
        { pg8::Gemm g{ACT, (const bf16_t*)(ws + WS_W2OUT), MR, 1024, 2816}; pg8::SplitOrder S; S.init(ML, MR, 1024, 2816, G, bid, 8); pg8::EpiResid E{a.out, a.out, XC, modl + 8 * 1024, PART, 0.5f};
          pg8::gemm_phase<pg8::EpiResid, pg8::SplitOrder, true, true>((PG8_LAS unsigned char*)lds, g, S, E); }
        GSYNC();
    }
    final_norm_phase(a.out, a.in[I_NFIN]);
}

extern "C" void kernel_launch(void* const* d_in, const int* in_sizes, int n_in, void* d_out, int out_size, void* d_ws, size_t ws_size, hipStream_t stream) {
    static int grid = 0;
    if (grid == 0) {
        if (n_in != 25 || out_size != ML * DM || ws_size < WS_END) { fprintf(stderr, "kernel_launch: unexpected shapes: n_in %d out %d ws %zu (need %zu)\n", n_in, out_size, ws_size, (size_t)WS_END); grid = -1; return; }
        int dev = 0, cus = 0, per_cu = 0;
        hipGetDevice(&dev); hipDeviceGetAttribute(&cus, hipDeviceAttributeMultiprocessorCount, dev);
        if (hipFuncSetAttribute((const void*)fwd_mega, hipFuncAttributeMaxDynamicSharedMemorySize, LDS_BYTES) != hipSuccess) { fprintf(stderr, "kernel_launch: hipFuncSetAttribute failed\n"); grid = -1; return; }
        hipOccupancyMaxActiveBlocksPerMultiprocessor(&per_cu, (const void*)fwd_mega, 512, LDS_BYTES);
        (void)hipGetLastError();
        fprintf(stderr, "kernel_launch: cus %d per_cu %d ws %zu\n", cus, per_cu, ws_size);
        grid = cus * (per_cu >= 1 ? 1 : 1);
    }
    if (grid < 0) return;
    Args a{};
    for (int i = 0; i < 25; ++i) a.in[i] = (const float*)d_in[i];
    a.out = (float*)d_out; a.ws = (unsigned char*)d_ws;
    if (hipMemsetAsync((unsigned char*)d_ws + WS_CTR, 0, WS_CTL_BYTES, stream) != hipSuccess) { fprintf(stderr, "kernel_launch: memset of the control words failed\n"); return; }
    void* args[] = {&a};
    hipError_t e = hipLaunchCooperativeKernel((void*)fwd_mega, dim3(grid), dim3(512), args, LDS_BYTES, stream);
    if (e != hipSuccess) fprintf(stderr, "kernel_launch: cooperative launch failed: %s (grid %d)\n", hipGetErrorString(e), grid);
}
```
